# Optimizing an MI355X kernel written in HIP

```python
import math, functools
import jax, jax.numpy as jnp
from jax import lax
import numpy as np

D_MODEL = 2048
BATCH = 32
SEQ = 256
DEPTH = 4
DEC_BATCH = 4
DEC_SEQ = 4096
PAST_LEN = 512

GRID_W = 64
N_BRANCH = 4
BRANCH_W = 512
MLA_HEADS = 8
MLA_NOPE = 64
MLA_ROPE = 32
MLA_V = 64
MLA_Q_LORA = 512
MLA_KV_LORA = 256
NA_HEADS = 8
NA_HD = 64
NA_WIN_R = 8
NA_WIN_C = 16
POOL_WINDOWS = (2, 4, 8, 16)
N_POOL_GROUPS = 4
POOL_GROUP = 128
POOL_W = N_POOL_GROUPS * POOL_GROUP
DIFF_HEADS = 4
DIFF_HD = 64
D_FF = 4 * D_MODEL
Q_BLOCK = 128
ROPE_THETA = 10000.0
RMS_EPS = 1e-6
NEG_INF = -1e30
NA_W = NA_HEADS * NA_HD
DIFF_QK_W = DIFF_HEADS * 2 * DIFF_HD
DIFF_V_W = DIFF_HEADS * 2 * DIFF_HD
MLA_SCALE = (MLA_NOPE + MLA_ROPE) ** -0.5
IN_SIZES = (MLA_Q_LORA, MLA_KV_LORA, MLA_ROPE, NA_W, NA_W, NA_W, POOL_W, DIFF_QK_W, DIFF_QK_W, DIFF_V_W, N_BRANCH * D_MODEL)
IN_COLS = sum(IN_SIZES)
IN_SPLITS = tuple(sum(IN_SIZES[:i + 1]) for i in range(len(IN_SIZES) - 1))

kernel_name = 'hybrid_flow_trunk_step'


def rms_norm(x, g):
    xf = x.astype(jnp.float32)
    y = xf * lax.rsqrt(jnp.mean(jnp.square(xf), axis=-1, keepdims=True) + RMS_EPS)
    return (y * g.astype(jnp.float32)).astype(x.dtype)


def split_heads(x, n):
    return x.reshape(*x.shape[:-1], n, x.shape[-1] // n)


def axial_rope(n_tokens, rot_dim):
    t = jnp.arange(n_tokens)
    row = (t // GRID_W).astype(jnp.float32)
    col = (t % GRID_W).astype(jnp.float32)
    n_freq = rot_dim // 4
    inv = ROPE_THETA ** (-jnp.arange(n_freq, dtype=jnp.float32) / n_freq)
    ang = jnp.concatenate([row[:, None] * inv, col[:, None] * inv], axis=-1)
    return jnp.cos(ang), jnp.sin(ang)


def apply_rope(x, cos, sin):
    xf = x.astype(jnp.float32)
    x1, x2 = jnp.split(xf, 2, axis=-1)
    c = cos[:, None, :]
    s = sin[:, None, :]
    return jnp.concatenate([x1 * c - x2 * s, x2 * c + x1 * s], axis=-1).astype(x.dtype)


def _query_blocks(x):
    b, t = x.shape[:2]
    return jnp.moveaxis(x.reshape(b, t // Q_BLOCK, Q_BLOCK, *x.shape[2:]), 1, 0)


def _merge_blocks(y):
    y = jnp.moveaxis(y, 0, 1)
    return y.reshape(y.shape[0], -1, *y.shape[3:])


def _probs(q, k, scale):
    s = jnp.einsum('bqhd,bkhd->bhqk', q, k, preferred_element_type=jnp.float32) * scale
    return jax.nn.softmax(s, axis=-1)


def attend_blocked(q, k, v, scale):
    def one_block(qb):
        p = _probs(qb, k, scale).astype(v.dtype)
        return jnp.einsum('bhqk,bkhd->bqhd', p, v)
    return _merge_blocks(lax.map(one_block, _query_blocks(q)))


def mla_compress(q_c, kv_c, lp):
    q = rms_norm(q_c, lp['g_q_lora']) @ lp['w_uq']
    return split_heads(q, MLA_HEADS), rms_norm(kv_c, lp['g_kv_lora'])


def mla_expand(ckv, k_r, lp):
    k_nope, v = jnp.split(split_heads(ckv @ lp['w_ukv'], MLA_HEADS), [MLA_NOPE], axis=-1)
    k_rope = jnp.broadcast_to(k_r[:, :, None, :], k_nope.shape[:-1] + (MLA_ROPE,))
    return jnp.concatenate([k_nope, k_rope], axis=-1), v


def diff_attention(q1, q2, k1, k2, v, lam_p, norm_g, li):
    b, t = q1.shape[:2]
    lam_init = 0.8 - 0.6 * math.exp(-0.3 * li)
    lp32 = lam_p.astype(jnp.float32)
    lam = jnp.exp(jnp.sum(lp32[0] * lp32[1])) - jnp.exp(jnp.sum(lp32[2] * lp32[3])) + lam_init
    scale = DIFF_HD ** -0.5
    def one_block(qs):
        a, c2 = qs
        p = _probs(a, k1, scale) - lam * _probs(c2, k2, scale)
        return jnp.einsum('bhqk,bkhd->bqhd', p.astype(v.dtype), v)
    o = _merge_blocks(lax.map(one_block, (_query_blocks(q1), _query_blocks(q2))))
    o = rms_norm(o, norm_g) * (1.0 - lam_init)
    return o.reshape(b, t, -1)


def neighbourhood_attention(q, k, v, k_ctx, v_ctx, rpb):
    b, t, h, dh = q.shape
    rows = t // GRID_W
    wr = min(NA_WIN_R, rows)
    ncb = GRID_W // NA_WIN_C
    gw = 2 * NA_WIN_C
    r = jnp.arange(rows)
    row_idx = jnp.clip(r - wr // 2, 0, rows - wr)[:, None] + jnp.arange(wr)
    j = jnp.arange(ncb)
    col_idx = jnp.clip(j * NA_WIN_C - NA_WIN_C // 2, 0, GRID_W - gw)[:, None] + jnp.arange(gw)
    qcol = jnp.arange(GRID_W).reshape(ncb, NA_WIN_C)
    col_start = jnp.clip(qcol - NA_WIN_C // 2, 0, GRID_W - NA_WIN_C)
    kc = col_idx[:, None, :]
    valid = (kc >= col_start[..., None]) & (kc < col_start[..., None] + NA_WIN_C)
    dr = row_idx - r[:, None] + NA_WIN_R - 1
    dc = jnp.clip(kc - qcol[..., None] + NA_WIN_C - 1, 0, 2 * NA_WIN_C - 2)
    bias = rpb[:, dr[:, None, None, :, None], dc[None, :, :, None, :]].astype(jnp.float32)
    bias = jnp.where(valid[None, None, :, :, None, :], bias, NEG_INF)
    bias = bias.reshape(h, rows, ncb, NA_WIN_C, wr * gw).transpose(1, 2, 0, 3, 4)
    gidx = (row_idx[:, None, :, None], col_idx[None, :, None, :])
    kg = k.reshape(b, rows, GRID_W, h, dh)[:, gidx[0], gidx[1]].reshape(b, rows, ncb, wr * gw, h, dh)
    vg = v.reshape(b, rows, GRID_W, h, dh)[:, gidx[0], gidx[1]].reshape(b, rows, ncb, wr * gw, h, dh)
    qg = q.reshape(b, rows, ncb, NA_WIN_C, h, dh)
    scale = dh ** -0.5
    s_win = jnp.einsum('brjqhd,brjkhd->brjhqk', qg, kg, preferred_element_type=jnp.float32) * scale + bias[None]
    s_ctx = jnp.einsum('brjqhd,blhd->brjhql', qg, k_ctx, preferred_element_type=jnp.float32) * scale
    p = jax.nn.softmax(jnp.concatenate([s_win, s_ctx], axis=-1), axis=-1).astype(v.dtype)
    nw = wr * gw
    o = (jnp.einsum('brjhqk,brjkhd->brjqhd', p[..., :nw], vg)
         + jnp.einsum('brjhql,blhd->brjqhd', p[..., nw:], v_ctx))
    return o.reshape(b, t, h * dh)


def multiscale_pool(u, pool_w, pool_scale):
    b, t, _ = u.shape
    uf = u.astype(jnp.float32)
    csum = jnp.concatenate([jnp.zeros((b, 1, POOL_W), jnp.float32), jnp.cumsum(uf, axis=1)], axis=1)
    pos = jnp.arange(t)
    groups = []
    for gi, w in enumerate(POOL_WINDOWS):
        sl = slice(gi * POOL_GROUP, (gi + 1) * POOL_GROUP)
        lo = jnp.clip(pos - w // 2, 0, t)
        hi = jnp.clip(pos + w // 2, 0, t)
        mean = (csum[:, hi, sl] - csum[:, lo, sl]) / (hi - lo).astype(jnp.float32)[None, :, None]
        groups.append(mean - uf[:, :, sl])
    pooled = jnp.stack(groups, axis=2).astype(u.dtype)
    mixed = jnp.einsum('btgc,gcd->btgd', pooled, pool_w).reshape(b, t, POOL_W)
    return mixed * pool_scale


def merge_branches(outs, gates, w_br, w_o):
    g = jax.nn.sigmoid(gates.astype(jnp.float32)).astype(gates.dtype)
    gs = jnp.split(g, N_BRANCH, axis=-1)
    merged = gs[0] * (outs[0] @ w_br[0])
    for bi in range(1, N_BRANCH):
        merged = merged + gs[bi] * (outs[bi] @ w_br[bi])
    return merged @ w_o


def context_mixers(h, lp, li):
    b, l, _ = h.shape
    (q_c, kv_c, k_r, na_q, na_k, na_v, pool_in, dq, dk, dv, gates) = jnp.split(h @ lp['w_in'], IN_SPLITS, axis=-1)
    q, ckv = mla_compress(q_c, kv_c, lp)
    k_a, v_a = mla_expand(ckv, k_r, lp)
    o_a = attend_blocked(q, k_a, v_a, MLA_SCALE).reshape(b, l, -1)
    na_k = split_heads(na_k, NA_HEADS)
    na_v = split_heads(na_v, NA_HEADS)
    o_b = attend_blocked(split_heads(na_q, NA_HEADS), na_k, na_v, NA_HD ** -0.5).reshape(b, l, -1)
    o_c = multiscale_pool(pool_in, lp['pool_w'], lp['pool_scale'])
    dq = split_heads(dq, DIFF_HEADS)
    dk = split_heads(dk, DIFF_HEADS)
    dv = split_heads(dv, DIFF_HEADS)
    o_d = diff_attention(dq[..., :DIFF_HD], dq[..., DIFF_HD:], dk[..., :DIFF_HD], dk[..., DIFF_HD:], dv,
                         lp['diff_lambda'], lp['diff_norm_g'], li)
    y = merge_branches((o_a, o_b, o_c, o_d), gates, lp['w_br'], lp['w_o'])
    return y, (ckv, k_r, na_k, na_v, dk, dv)


def latent_mixers(h, lp, li, ctx, rope_mla, rope_diff):
    ckv_c, kr_c, nak_c, nav_c, dk_c, dv_c = ctx
    b, t, _ = h.shape
    (q_c, kv_c, k_r, na_q, na_k, na_v, pool_in, dq, dk, dv, gates) = jnp.split(h @ lp['w_in'], IN_SPLITS, axis=-1)
    q, ckv = mla_compress(q_c, kv_c, lp)
    q = jnp.concatenate([q[..., :MLA_NOPE], apply_rope(q[..., MLA_NOPE:], *rope_mla)], axis=-1)
    k_r = apply_rope(k_r[:, :, None, :], *rope_mla)[:, :, 0, :]
    k_lat, v_lat = mla_expand(ckv, k_r, lp)
    k_ctx, v_ctx = mla_expand(ckv_c, kr_c, lp)
    o_a = attend_blocked(q, jnp.concatenate([k_lat, k_ctx], axis=1), jnp.concatenate([v_lat, v_ctx], axis=1),
                         MLA_SCALE).reshape(b, t, -1)
    o_b = neighbourhood_attention(split_heads(na_q, NA_HEADS), split_heads(na_k, NA_HEADS),
                                  split_heads(na_v, NA_HEADS), nak_c, nav_c, lp['na_rpb'])
    o_c = multiscale_pool(pool_in, lp['pool_w'], lp['pool_scale'])
    dq = split_heads(dq, DIFF_HEADS)
    dk = split_heads(dk, DIFF_HEADS)
    q1 = apply_rope(dq[..., :DIFF_HD], *rope_diff)
    q2 = apply_rope(dq[..., DIFF_HD:], *rope_diff)
    k1 = jnp.concatenate([apply_rope(dk[..., :DIFF_HD], *rope_diff), dk_c[..., :DIFF_HD]], axis=1)
    k2 = jnp.concatenate([apply_rope(dk[..., DIFF_HD:], *rope_diff), dk_c[..., DIFF_HD:]], axis=1)
    vd = jnp.concatenate([split_heads(dv, DIFF_HEADS), dv_c], axis=1)
    o_d = diff_attention(q1, q2, k1, k2, vd, lp['diff_lambda'], lp['diff_norm_g'], li)
    y = merge_branches((o_a, o_b, o_c, o_d), gates, lp['w_br'], lp['w_o'])
    return y, None


def trunk_layer(x, cond, lp, mixer):
    mod = jax.nn.silu(cond) @ lp['w_mod'] + lp['b_mod']
    sh1, sc1, g1, sh2, sc2, g2 = jnp.split(mod[:, None, :], 6, axis=-1)
    gn = lp['g_norm']
    h = rms_norm(x, gn[0]) * (1.0 + sc1) + sh1
    y, extra = mixer(h)
    x = x + g1 * rms_norm(y, gn[1])
    h = rms_norm(x, gn[2]) * (1.0 + sc2) + sh2
    y = jnp.square(jax.nn.relu(h @ lp['w_up'])) @ lp['w_down']
    x = x + g2 * rms_norm(y, gn[3])
    return x, extra


def setup_inputs(seed: int = 0) -> dict:
    key = jax.random.key(seed)
    ks = jax.random.split(key, 32)
    def nrm(i, shape, scale=1.0):
        return jax.random.normal(ks[i], shape, jnp.float32) * scale
    return {
        'x_prompt': nrm(0, (BATCH, SEQ, D_MODEL)),
        'x_sample': nrm(1, (DEC_BATCH, DEC_SEQ, D_MODEL)),
        'cache_mla_ckv': nrm(2, (DEC_BATCH, DEPTH, PAST_LEN, MLA_KV_LORA)),
        'cache_mla_krope': nrm(3, (DEC_BATCH, DEPTH, PAST_LEN, MLA_ROPE)),
        'cache_na_k': nrm(4, (DEC_BATCH, DEPTH, PAST_LEN, NA_HEADS, NA_HD)),
        'cache_na_v': nrm(5, (DEC_BATCH, DEPTH, PAST_LEN, NA_HEADS, NA_HD)),
        'cache_diff_k': nrm(6, (DEC_BATCH, DEPTH, PAST_LEN, DIFF_HEADS, 2 * DIFF_HD)),
        'cache_diff_v': nrm(7, (DEC_BATCH, DEPTH, PAST_LEN, DIFF_HEADS, 2 * DIFF_HD)),
        'c': nrm(8, (DEC_BATCH, D_MODEL)),
        'c_ctx': nrm(9, (D_MODEL,)),
        'w_mod': nrm(10, (DEPTH, D_MODEL, 6 * D_MODEL), 0.5 * D_MODEL ** -0.5),
        'b_mod': nrm(11, (DEPTH, 6 * D_MODEL), 0.01),
        'g_norm': 1.0 + nrm(12, (DEPTH, 4, D_MODEL), 0.02),
        'w_in': nrm(13, (DEPTH, D_MODEL, IN_COLS), D_MODEL ** -0.5),
        'g_q_lora': 1.0 + nrm(14, (DEPTH, MLA_Q_LORA), 0.02),
        'g_kv_lora': 1.0 + nrm(15, (DEPTH, MLA_KV_LORA), 0.02),
        'w_uq': nrm(16, (DEPTH, MLA_Q_LORA, MLA_HEADS * (MLA_NOPE + MLA_ROPE)), MLA_Q_LORA ** -0.5),
        'w_ukv': nrm(17, (DEPTH, MLA_KV_LORA, MLA_HEADS * (MLA_NOPE + MLA_V)), MLA_KV_LORA ** -0.5),
        'na_rpb': nrm(18, (DEPTH, NA_HEADS, 2 * NA_WIN_R - 1, 2 * NA_WIN_C - 1), 0.1),
        'pool_w': nrm(19, (DEPTH, N_POOL_GROUPS, POOL_GROUP, POOL_GROUP), POOL_GROUP ** -0.5),
        'pool_scale': 1.0 + nrm(20, (DEPTH, POOL_W), 0.1),
        'diff_lambda': nrm(21, (DEPTH, 4, DIFF_HD), 0.1),
        'diff_norm_g': 1.0 + nrm(22, (DEPTH, 2 * DIFF_HD), 0.02),
        'w_br': nrm(23, (DEPTH, N_BRANCH, BRANCH_W, D_MODEL), BRANCH_W ** -0.5),
        'w_o': nrm(24, (DEPTH, D_MODEL, D_MODEL), D_MODEL ** -0.5),
        'w_up': nrm(25, (DEPTH, D_MODEL, D_FF), D_MODEL ** -0.5),
        'w_down': nrm(26, (DEPTH, D_FF, D_MODEL), D_FF ** -0.5),
    }


def reference(x_prompt, x_sample, cache_mla_ckv, cache_mla_krope, cache_na_k, cache_na_v, cache_diff_k,
              cache_diff_v, c, c_ctx, w_mod, b_mod, g_norm, w_in, g_q_lora, g_kv_lora, w_uq, w_ukv, na_rpb,
              pool_w, pool_scale, diff_lambda, diff_norm_g, w_br, w_o, w_up, w_down):
    params = dict(w_mod=w_mod, b_mod=b_mod, g_norm=g_norm, w_in=w_in, g_q_lora=g_q_lora, g_kv_lora=g_kv_lora,
                  w_uq=w_uq, w_ukv=w_ukv, na_rpb=na_rpb, pool_w=pool_w, pool_scale=pool_scale,
                  diff_lambda=diff_lambda, diff_norm_g=diff_norm_g, w_br=w_br, w_o=w_o, w_up=w_up, w_down=w_down)
    xp = x_prompt
    cond_ctx = c_ctx[None, :]
    ctx_states = []
    for i in range(DEPTH):
        lp = {name: arr[i] for name, arr in params.items()}
        xp, ctx_i = trunk_layer(xp, cond_ctx, lp, functools.partial(context_mixers, lp=lp, li=i))
        ctx_states.append(ctx_i)
    state_mla_ckv = jnp.stack([s[0] for s in ctx_states], axis=1)
    state_mla_krope = jnp.stack([s[1] for s in ctx_states], axis=1)
    state_na_k = jnp.stack([s[2] for s in ctx_states], axis=1)
    state_na_v = jnp.stack([s[3] for s in ctx_states], axis=1)
    state_diff_k = jnp.stack([s[4] for s in ctx_states], axis=1)
    state_diff_v = jnp.stack([s[5] for s in ctx_states], axis=1)
    n_lat = x_sample.shape[1]
    rope_mla = axial_rope(n_lat, MLA_ROPE)
    rope_diff = axial_rope(n_lat, DIFF_HD)
    xs = x_sample
    for i in range(DEPTH):
        lp = {name: arr[i] for name, arr in params.items()}
        ctx_i = (cache_mla_ckv[:, i], cache_mla_krope[:, i], cache_na_k[:, i], cache_na_v[:, i],
                 cache_diff_k[:, i], cache_diff_v[:, i])
        xs, _ = trunk_layer(xs, c, lp, functools.partial(latent_mixers, lp=lp, li=i, ctx=ctx_i,
                                                         rope_mla=rope_mla, rope_diff=rope_diff))
    return (xp, xs, state_mla_ckv, state_mla_krope, state_na_k, state_na_v, state_diff_k, state_diff_v)
```

```cpp
#include <hip/hip_runtime.h>
#include <cstdio>
#include <cstdint>

#ifndef REP_T23
#define REP_T23 1
#endif
#ifndef REP_G2
#define REP_G2 1
#endif
#ifndef REP_G3
#define REP_G3 1
#endif
#ifndef REP_G4
#define REP_G4 1
#endif
#ifndef REP_G56
#define REP_G56 1
#endif
#ifndef REP_T1
#define REP_T1 1
#endif
#ifndef REP_A1
#define REP_A1 1
#endif
#ifndef REP_G1
#define REP_G1 1
#endif
#ifndef ATTREP
#define ATTREP 0
#endif
#ifndef ATTMASK
#define ATTMASK 63
#endif
#ifndef PHMASK
#define PHMASK 0xFFFFF
#endif
#ifndef MK_MULTI
#define MK_MULTI 0
#endif

#define GAS __attribute__((address_space(1)))
#define LAS __attribute__((address_space(3)))
typedef unsigned short bf16;
typedef unsigned v4u __attribute__((ext_vector_type(4)));
typedef unsigned v2u __attribute__((ext_vector_type(2)));
typedef float f32x4 __attribute__((ext_vector_type(4)));
typedef float f32x2 __attribute__((ext_vector_type(2)));
typedef GAS unsigned gu32;
#define RLX_AGENT __ATOMIC_RELAXED, __HIP_MEMORY_SCOPE_AGENT
#define LDS_WAIT() asm volatile("s_waitcnt lgkmcnt(0)" ::: "memory")
#define VM_WAIT() asm volatile("s_waitcnt vmcnt(0)" ::: "memory")

constexpr int DM = 2048, NCTX = 8192, MTOK = 24576, MKV = 26624, NLAYER = 4, LSEQ = 4096, CSEQ = 256, PAST = 512, FF = 8192;
constexpr int PW = 4608;
constexpr int NW_IN = 12800;
constexpr int C_QC = 0, C_KVC = 512, C_NAQ = 768, C_NAK = 1280, C_NAV = 1792, C_POOL = 2304, C_DQ = 2816, C_DK = 3328, C_DV = 3840, C_KR = 4352, C_GATE = 4608;
constexpr int IN_COLS = 12576;
constexpr float RMS_EPS = 1e-6f;
constexpr size_t OUT_X = 0, OUT_CKV = 50331648, OUT_KROPE = 58720256, OUT_NAK = 59768832, OUT_NAV = 76546048, OUT_DK = 93323264, OUT_DV = 110100480, OUT_END = 126877696;

constexpr size_t MiB = 1u << 20;
constexpr size_t WS_CTL = 0, CTL_ZERO_BYTES = 1 * MiB;
constexpr size_t WS_MOD = 1 * MiB;
constexpr size_t WS_ROPE_MLA = 2 * MiB;
constexpr size_t WS_ROPE_DIFF = 2 * MiB + 512 * 1024;
constexpr size_t WS_MODP = 4 * MiB;
constexpr size_t WS_WT = 20 * MiB;
constexpr size_t WT_IN = 0, WT_UQ = WT_IN + (size_t)12800 * 2048, WT_UKV = WT_UQ + (size_t)768 * 512, WT_POOL = WT_UKV + (size_t)1024 * 256,
                 WT_BR = WT_POOL + (size_t)512 * 512, WT_O = WT_BR + (size_t)2048 * 2048, WT_UP = WT_O + (size_t)2048 * 2048, WT_DN = WT_UP + (size_t)8192 * 2048,
                 WT_END = WT_DN + (size_t)2048 * 8192;
static_assert(WT_END * 2 <= 132 * MiB, "weights fit");
constexpr size_t WS_H = 152 * MiB;
constexpr size_t WS_P = 248 * MiB;
constexpr size_t WS_GT = 464 * MiB;
constexpr size_t WS_MID = 848 * MiB;
constexpr size_t WS_Y = WS_MID;
constexpr size_t WS_QN = WS_MID + 0 * MiB;
constexpr size_t WS_CKV = WS_MID + 24 * MiB;
constexpr size_t WS_KR = WS_MID + 37 * MiB;
constexpr size_t WS_POOLED = WS_MID + 39 * MiB;
constexpr size_t WS_QM = WS_MID + 63 * MiB;
constexpr size_t WS_KVX = WS_MID + 99 * MiB;
constexpr size_t WS_NAKC = WS_MID + 151 * MiB, WS_NAVC = WS_MID + 153 * MiB, WS_DKC = WS_MID + 155 * MiB, WS_DVC = WS_MID + 157 * MiB;
constexpr size_t WS_DO = WS_MID + 159 * MiB;
constexpr size_t WS_OALL = WS_MID + 255 * MiB;
constexpr size_t WS_END = WS_MID + 351 * MiB;

constexpr int CW_TMO = 0, CW_BAR = 4096;

constexpr int RING_BYTES = 131072, LDSCTL_OFF = RING_BYTES, MISC_OFF = LDSCTL_OFF + 320, LDS_BYTES = 147456;
constexpr int NWAVES = 8;

__device__ __forceinline__ unsigned cvt_pk_bf16(float lo, float hi) { unsigned r; asm volatile("v_cvt_pk_bf16_f32 %0, %1, %2" : "=v"(r) : "v"(lo), "v"(hi)); return r; }
__device__ __forceinline__ float bflo(unsigned w) { return __uint_as_float(w << 16); }
__device__ __forceinline__ float bfhi(unsigned w) { return __uint_as_float(w & 0xffff0000u); }
__device__ __forceinline__ float bf1(bf16 v) { return __uint_as_float(((unsigned)v) << 16); }
__device__ __forceinline__ bf16 f2bf(float f) { return (bf16)(cvt_pk_bf16(f, 0.f) & 0xffffu); }
__device__ __forceinline__ float wave_sum(float v) {
#pragma unroll
    for (int o = 1; o < 64; o <<= 1) v += __shfl_xor(v, o);
    return v;
}

namespace pg8 {
#define PG8_LAS __attribute__((address_space(3)))
typedef unsigned short bf16_t;
typedef short bf16x8 __attribute__((ext_vector_type(8)));
typedef unsigned u32x4 __attribute__((ext_vector_type(4)));
constexpr int BM = 256, BK = 64, HALF = 128, HTB = HALF * BK * 2, STAGE_BYTES = 8 * HTB, NXCD = 8, WGM = 8;

__host__ __device__ __forceinline__ int lds_byte(int r, int c) { const int st = (r >> 4) * 2 + (c >> 5), rr = r & 15, cc = c & 31, ob = rr * 64 + cc * 2; return st * 1024 + (ob ^ (((ob >> 9) & 1) << 5)); }
__host__ __device__ __forceinline__ void stage_rc(int b, int& R, int& C) { const int st = b / 1024, sb = b % 1024, swz = sb ^ (((sb >> 9) & 1) << 5); R = (st >> 1) * 16 + swz / 64; C = (st & 1) * 32 + (swz % 64) / 2; }
__host__ __device__ __forceinline__ int perm32(int rho) { const int n = rho >> 4, i = rho & 15; return 8 * (i >> 2) + 4 * n + (i & 3); }

struct Unit { int pm, pn; };
struct Gemm { const bf16_t* A; const bf16_t* Bt; int M, N, K, lda, ldb; };

struct StaticOrder {
    int nM, nN, nwg, G, c;
    __host__ __device__ void init(int M, int N, int G_, int c_) { nM = M / BM; nN = N / BM; nwg = nM * nN; G = G_; c = c_; }
    __host__ __device__ bool next(int i, Unit& u) const {
        const long L = (long)i * G + c; if (L >= nwg) return false;
        int wgid = (int)L; { const int q = nwg / NXCD, r = nwg % NXCD, xcd = wgid % NXCD, off = wgid / NXCD; wgid = (xcd < r ? xcd * (q + 1) : r * (q + 1) + (xcd - r) * q) + off; }
        const int nig = WGM * nN, gid = wgid / nig, fm = gid * WGM, gsz = (nM - fm) < WGM ? (nM - fm) : WGM;
        u.pm = fm + ((wgid % nig) % gsz); u.pn = (wgid % nig) / gsz; return true;
    }
};

enum { EP_BF16 = 0, EP_G1 = 1, EP_RELU2 = 2, EP_F32 = 3, EP_POOL = 4, EP_MERGE = 5 };
template <int MODE> struct Epi {
    static constexpr bool PERM = true, MIDK = (MODE == EP_MERGE);
    void* O; int ldc; int col_off;
    const float* aux;
    bf16_t* gates;
    int sig_pn;
    float* state; int layer;
    __device__ __forceinline__ void operator()(f32x4 (&acc)[2][2][4][2], const Unit& u, int wr, int wc, int fr, int fq) const {
        const int row0 = u.pm * BM + wr * 64 + fr; const int colt = u.pn * BM + wc * 32 + 8 * fq;
        const int lidx = ((wr * 4 + wc) * 64 + fq * 16 + fr) * 8;
        const bool sig = (MODE == EP_G1) && (u.pn >= sig_pn);
        float* st = nullptr; int st_pitch = 512;
        if (MODE == EP_G1) { if (u.pm < 32) { const int pn = u.pn; size_t ob = 0; int c0 = -1;
            if (pn == 5 || pn == 6) { ob = OUT_NAK; c0 = (pn - 5) * 256; } else if (pn == 7 || pn == 8) { ob = OUT_NAV; c0 = (pn - 7) * 256; }
            else if (pn == 13 || pn == 14) { ob = OUT_DK; c0 = (pn - 13) * 256; } else if (pn == 15 || pn == 16) { ob = OUT_DV; c0 = (pn - 15) * 256; }
            else if (pn == 17) { ob = OUT_KROPE; c0 = 0; st_pitch = 32; }
            if (c0 >= 0) st = state + ob + (size_t)(u.pm * 4 + layer) * 256 * st_pitch + c0 + wc * 32 + 8 * fq; } }
        constexpr size_t ESZ = (MODE == EP_F32) ? 4 : 2;
        char* const pb0 = (char*)O + ((size_t)row0 * ldc + col_off + colt) * ESZ;
        f32x4 sc[2][2];
        if (MODE == EP_POOL) {
#pragma unroll
            for (int bj = 0; bj < 2; ++bj)
#pragma unroll
                for (int n = 0; n < 2; ++n) sc[bj][n] = *(const f32x4*)(aux + colt + bj * HALF + 4 * n);
        }
        bf16_t* gt = nullptr;
        if (MODE == EP_G1) gt = gates + ((size_t)u.pm * 32 + (u.pn - sig_pn)) * 65536 + lidx;
        u32x4 gfin[2][4][2];
        if (MODE == EP_MERGE) { gt = gates + ((size_t)u.pm * 32 + 24 + u.pn) * 65536 + lidx;
#pragma unroll
            for (int ai = 0; ai < 2; ++ai)
#pragma unroll
                for (int m = 0; m < 4; ++m)
#pragma unroll
                    for (int bj = 0; bj < 2; ++bj) gfin[ai][m][bj] = __builtin_nontemporal_load((const u32x4*)(gt + ((ai * 4 + m) * 2 + bj) * 4096));
            __builtin_amdgcn_sched_barrier(0); }
#pragma unroll
        for (int ai = 0; ai < 2; ++ai)
#pragma unroll
            for (int m = 0; m < 4; ++m) {
                const int rit = wr * 64 + fr + ai * HALF + m * 16;
                const size_t row = (size_t)(u.pm * BM + rit);
#pragma unroll
                for (int bj = 0; bj < 2; ++bj) {
                    f32x4 v0 = acc[ai][bj][m][0], v1 = acc[ai][bj][m][1];
                    const int col = colt + bj * HALF;
                    const int gidx = ((ai * 4 + m) * 2 + bj) * 4096;
                    if (MODE == EP_G1) {
                        if (sig) {
#pragma unroll
                            for (int e = 0; e < 4; ++e) { v0[e] = fminf(1.f + __builtin_amdgcn_exp2f(-1.4426950408889634f * v0[e]), 1e30f);
                                                          v1[e] = fminf(1.f + __builtin_amdgcn_exp2f(-1.4426950408889634f * v1[e]), 1e30f); }
                            u32x4 w; w.x = cvt_pk_bf16(v0[0], v0[1]); w.y = cvt_pk_bf16(v0[2], v0[3]); w.z = cvt_pk_bf16(v1[0], v1[1]); w.w = cvt_pk_bf16(v1[2], v1[3]);
                            __builtin_nontemporal_store(w, (u32x4*)(gt + gidx));
                            continue;
                        }
                        if (st) { if (st_pitch == 512 || (bj == 0 && wc == 0)) { float* p = st + (size_t)rit * st_pitch + bj * HALF; *(f32x4*)p = v0; *(f32x4*)(p + 4) = v1; } }
                    }
                    if (MODE == EP_RELU2) {
#pragma unroll
                        for (int e = 0; e < 4; ++e) { const float a = fmaxf(v0[e], 0.f), b = fmaxf(v1[e], 0.f); v0[e] = a * a; v1[e] = b * b; } }
                    if (MODE == EP_POOL) { v0 = v0 * sc[bj][0]; v1 = v1 * sc[bj][1]; }
                    if (MODE == EP_MERGE) {
                        const u32x4 g = gfin[ai][m][bj];
                        v0[0] *= __builtin_amdgcn_rcpf(bflo(g.x)); v0[1] *= __builtin_amdgcn_rcpf(bfhi(g.x)); v0[2] *= __builtin_amdgcn_rcpf(bflo(g.y)); v0[3] *= __builtin_amdgcn_rcpf(bfhi(g.y));
                        v1[0] *= __builtin_amdgcn_rcpf(bflo(g.z)); v1[1] *= __builtin_amdgcn_rcpf(bfhi(g.z)); v1[2] *= __builtin_amdgcn_rcpf(bflo(g.w)); v1[3] *= __builtin_amdgcn_rcpf(bfhi(g.w));
                    }
                    char* const prow = pb0 + (size_t)((ai * HALF + m * 16) * ldc) * ESZ;
                    if (MODE == EP_F32) {
                        float* p = (float*)(prow + bj * HALF * ESZ);
                        *(f32x4*)p = v0; *(f32x4*)(p + 4) = v1;
                    } else {
                        u32x4 w; w.x = cvt_pk_bf16(v0[0], v0[1]); w.y = cvt_pk_bf16(v0[2], v0[3]); w.z = cvt_pk_bf16(v1[0], v1[1]); w.w = cvt_pk_bf16(v1[2], v1[3]);
                        *(u32x4*)(prow + bj * HALF * ESZ) = w;
                    }
                }
            }
    }
    __device__ __forceinline__ void midk(f32x4 (&acc)[2][2][4][2], const Unit& u, int seg, int wr, int wc, int fr, int fq) const {
        const int lidx = ((wr * 4 + wc) * 64 + fq * 16 + fr) * 8;
        const bf16_t* ta = gates + ((size_t)u.pm * 32 + (seg - 1) * 8 + u.pn) * 65536 + lidx;
        const bf16_t* tb = ta + (size_t)8 * 65536;
#pragma unroll
        for (int ai = 0; ai < 2; ++ai) {
            u32x4 ga[4][2], gb[4][2];
#pragma unroll
            for (int m = 0; m < 4; ++m)
#pragma unroll
                for (int bj = 0; bj < 2; ++bj) { const int gidx = ((ai * 4 + m) * 2 + bj) * 4096; ga[m][bj] = __builtin_nontemporal_load((const u32x4*)(ta + gidx)); gb[m][bj] = __builtin_nontemporal_load((const u32x4*)(tb + gidx)); }
            __builtin_amdgcn_sched_barrier(0);
#pragma unroll
            for (int m = 0; m < 4; ++m)
#pragma unroll
                for (int bj = 0; bj < 2; ++bj) {
                    const u32x4 a = ga[m][bj], b = gb[m][bj];
                    f32x4& v0 = acc[ai][bj][m][0]; f32x4& v1 = acc[ai][bj][m][1];
                    v0[0] *= bflo(b.x) * __builtin_amdgcn_rcpf(bflo(a.x)); v0[1] *= bfhi(b.x) * __builtin_amdgcn_rcpf(bfhi(a.x));
                    v0[2] *= bflo(b.y) * __builtin_amdgcn_rcpf(bflo(a.y)); v0[3] *= bfhi(b.y) * __builtin_amdgcn_rcpf(bfhi(a.y));
                    v1[0] *= bflo(b.z) * __builtin_amdgcn_rcpf(bflo(a.z)); v1[1] *= bfhi(b.z) * __builtin_amdgcn_rcpf(bfhi(a.z));
                    v1[2] *= bflo(b.w) * __builtin_amdgcn_rcpf(bflo(a.w)); v1[3] *= bfhi(b.w) * __builtin_amdgcn_rcpf(bfhi(a.w));
                }
            __builtin_amdgcn_sched_barrier(0);
        }
    }
};

template <class EpiT, bool ALIGN_EPI = true>
__device__ __forceinline__ void gemm_phase(PG8_LAS unsigned char* lds, const Gemm g, const StaticOrder& S, const EpiT& E) {
    int tid = threadIdx.x; asm volatile("" : "+v"(tid));
    const int wid = __builtin_amdgcn_readfirstlane(tid >> 6), lane = tid & 63, wr = wid >> 2, wc = wid & 3, fr = lane & 15, fq = lane >> 4;
    int K = g.K; asm volatile("" : "+s"(K)); const int nt = K / BK;
    unsigned voffA[2], voffB[2];
#pragma unroll
    for (int i = 0; i < 2; ++i) { int R, C; stage_rc(tid * 16 + i * 8192, R, C); const int Rb = EpiT::PERM ? ((R & ~31) + perm32(R & 31)) : R;
        voffA[i] = (unsigned)(R * g.lda + C) * 2u; voffB[i] = (unsigned)(Rb * g.ldb + C) * 2u; }
    const size_t kstep = (size_t)(BK * 2);
    const size_t hstepA = (size_t)HALF * g.lda * 2, hstepB = (size_t)HALF * g.ldb * 2;
    const size_t tstepA = 2 * hstepA, tstepB = 2 * hstepB;
    const unsigned ldsw = (unsigned)wid * 1024u;
    const unsigned ldsb = (unsigned)__builtin_amdgcn_readfirstlane((int)((unsigned)(uintptr_t)lds + ldsw));
    const int aoff = lds_byte(wr * 64 + fr, fq * 8), boff = lds_byte(wc * 32 + fr, fq * 8);
#define PG8_SA(b, h) (((b) * 2 + (h)) * HTB)
#define PG8_SB(b, h) ((4 + (b) * 2 + (h)) * HTB)
#define PG8_STAGE(bufoff, gbase, voff) do { _Pragma("unroll") for (int _i = 0; _i < 2; ++_i) { unsigned keep_;                              \
        asm volatile("s_mov_b32 %0, m0\n\ts_mov_b32 m0, %3\n\ts_nop 0\n\tglobal_load_lds_dwordx4 %1, %2\n\ts_mov_b32 m0, %0"                        \
                     : "=&s"(keep_) : "v"((voff)[_i]), "s"((const char*)(gbase)), "s"(ldsb + (unsigned)((bufoff) + _i * 8192)) : "memory"); } } while (0)
#define PG8_LDA(dst, b, h) do { _Pragma("unroll") for (int m = 0; m < 4; ++m) _Pragma("unroll") for (int k = 0; k < 2; ++k) dst[m][k] = *(const PG8_LAS bf16x8*)(lds + PG8_SA(b, h) + aoff + m * 2048 + k * 1024); } while (0)
#define PG8_LDB(dst, b, h) do { _Pragma("unroll") for (int n = 0; n < 2; ++n) _Pragma("unroll") for (int k = 0; k < 2; ++k) dst[n][k] = *(const PG8_LAS bf16x8*)(lds + PG8_SB(b, h) + boff + n * 2048 + k * 1024); } while (0)
#define PG8_MMA(ai, bj, At, Bt) do { __builtin_amdgcn_s_setprio(1); _Pragma("unroll") for (int m = 0; m < 4; ++m) _Pragma("unroll") for (int n = 0; n < 2; ++n) _Pragma("unroll") for (int k = 0; k < 2; ++k) \
        acc[ai][bj][m][n] = __builtin_amdgcn_mfma_f32_16x16x32_bf16(Bt[n][k], At[m][k], acc[ai][bj][m][n], 0, 0, 0); __builtin_amdgcn_s_setprio(0); } while (0)
#define PG8_WAIT_V(n) asm volatile("s_waitcnt vmcnt(" #n ")" ::: "memory")
#define PG8_WAIT_L(n) asm volatile("s_waitcnt lgkmcnt(" #n ")" ::: "memory")
#define PG8_BAR __builtin_amdgcn_s_barrier()
#define PG8_SCHED __builtin_amdgcn_sched_barrier(0)
    Unit cur, nxt; int ui = 0;
    if (!S.next(0, cur)) return;
    f32x4 acc[2][2][4][2];
#pragma unroll
    for (int a = 0; a < 2; ++a)
#pragma unroll
        for (int b = 0; b < 2; ++b)
#pragma unroll
            for (int m = 0; m < 4; ++m)
#pragma unroll
                for (int n = 0; n < 2; ++n) acc[a][b][m][n] = (f32x4){0.f, 0.f, 0.f, 0.f};
    bf16x8 At[4][2], B0[2][2], B1[2][2];
    const char* cA = (const char*)g.A + (size_t)cur.pm * tstepA; const char* cB = (const char*)g.Bt + (size_t)cur.pn * tstepB;
    PG8_STAGE(PG8_SB(0, 0), cB, voffB); PG8_STAGE(PG8_SB(0, 1), cB + hstepB, voffB); PG8_STAGE(PG8_SA(0, 0), cA, voffA); PG8_STAGE(PG8_SA(0, 1), cA + hstepA, voffA);
    if (wr == 1) PG8_BAR;
    PG8_WAIT_V(2); PG8_BAR;
    PG8_STAGE(PG8_SB(1, 0), cB + kstep, voffB); PG8_STAGE(PG8_SA(1, 0), cA + kstep, voffA); PG8_STAGE(PG8_SB(1, 1), cB + hstepB + kstep, voffB);
    PG8_WAIT_V(6); PG8_BAR;
    for (;;) {
        const bool has_next = S.next(ui + 1, nxt);
        const char* nA = has_next ? (const char*)g.A + (size_t)nxt.pm * tstepA : cA; const char* nB = has_next ? (const char*)g.Bt + (size_t)nxt.pn * tstepB : cB;
#pragma unroll 1
        for (int t = 0; t < nt; t += 2) {
            if constexpr (EpiT::MIDK) { if (t != 0 && (t & 7) == 0) E.midk(acc, cur, t >> 3, wr, wc, fr, fq); }
            const bool last = (t == nt - 2);
            const char* a1 = cA + (size_t)(t + 1) * kstep;
            const char* a2 = last ? nA : cA + (size_t)(t + 2) * kstep; const char* b2 = last ? nB : cB + (size_t)(t + 2) * kstep;
            const char* a3 = a2 + kstep; const char* b3 = b2 + kstep;
            PG8_LDB(B0, 0, 0); PG8_LDB(B1, 0, 1); PG8_SCHED; PG8_LDA(At, 0, 0); PG8_STAGE(PG8_SA(1, 1), a1 + hstepA, voffA);
            PG8_WAIT_V(8); PG8_WAIT_L(0); PG8_BAR; PG8_MMA(0, 0, At, B0); PG8_MMA(0, 1, At, B1); PG8_BAR; PG8_SCHED;
            PG8_LDA(At, 0, 1); PG8_STAGE(PG8_SB(0, 0), b2, voffB); PG8_STAGE(PG8_SB(0, 1), b2 + hstepB, voffB); PG8_STAGE(PG8_SA(0, 0), a2, voffA);
            PG8_WAIT_V(8); PG8_WAIT_L(0); PG8_BAR; PG8_MMA(1, 0, At, B0); PG8_MMA(1, 1, At, B1); PG8_BAR; PG8_SCHED;
            PG8_LDB(B0, 1, 0); PG8_LDB(B1, 1, 1); PG8_SCHED; PG8_LDA(At, 1, 0); PG8_STAGE(PG8_SA(0, 1), a2 + hstepA, voffA);
            PG8_WAIT_V(8); PG8_WAIT_L(0); PG8_BAR; PG8_MMA(0, 0, At, B0); PG8_MMA(0, 1, At, B1); PG8_BAR; PG8_SCHED;
            PG8_LDA(At, 1, 1); PG8_STAGE(PG8_SB(1, 0), b3, voffB); PG8_STAGE(PG8_SB(1, 1), b3 + hstepB, voffB); PG8_STAGE(PG8_SA(1, 0), a3, voffA);
            PG8_WAIT_V(8); PG8_WAIT_L(0); PG8_BAR; PG8_MMA(1, 0, At, B0); PG8_MMA(1, 1, At, B1); PG8_BAR; PG8_SCHED;
        }
        if constexpr (ALIGN_EPI) { if (wr == 0) PG8_BAR; }
        asm volatile("s_nop 15\n\ts_nop 7" ::: "memory");
        E(acc, cur, wr, wc, fr, fq);
        if (!has_next) break;
#pragma unroll
        for (int a = 0; a < 2; ++a)
#pragma unroll
            for (int b = 0; b < 2; ++b)
#pragma unroll
                for (int m = 0; m < 4; ++m)
#pragma unroll
                    for (int n = 0; n < 2; ++n) acc[a][b][m][n] = (f32x4){0.f, 0.f, 0.f, 0.f};
        cur = nxt; cA = nA; cB = nB; ++ui;
        if constexpr (ALIGN_EPI) { if (wr == 1) PG8_BAR; }
    }
    PG8_WAIT_V(0);
    if constexpr (!ALIGN_EPI) { if (wr == 0) PG8_BAR; }
    PG8_BAR;
#undef PG8_SA
#undef PG8_SB
#undef PG8_STAGE
#undef PG8_LDA
#undef PG8_LDB
#undef PG8_MMA
#undef PG8_WAIT_V
#undef PG8_WAIT_L
#undef PG8_BAR
#undef PG8_SCHED
}
}

namespace att {
typedef short bf16x8 __attribute__((ext_vector_type(8)));
typedef short s16x4 __attribute__((ext_vector_type(4)));
typedef float f32x16 __attribute__((ext_vector_type(16)));
typedef unsigned u32x4 __attribute__((ext_vector_type(4)));
#define SBAR() __builtin_amdgcn_sched_barrier(0)
__device__ __forceinline__ int crow(int r, int hi) { return (r & 3) + 8 * (r >> 2) + 4 * hi; }
__device__ __forceinline__ unsigned cvtpk(float lo, float hi) { unsigned r; asm volatile("v_cvt_pk_bf16_f32 %0, %1, %2" : "=v"(r) : "v"(lo), "v"(hi)); return r; }
template <int KP> __device__ __forceinline__ int kswz(int row, int colB) {
    if (KP == 256) return row * 256 + (colB ^ ((row & 15) << 4));
    else return row * 128 + (colB ^ (((row >> 1) & 7) << 4));
}
constexpr float THR = 8.f;
#define max3f(a_, b_, c_) __builtin_fmaxf(__builtin_fmaxf((a_), (b_)), (c_))
__device__ __forceinline__ void partialSM(f32x16& p0, f32x16& p1, float& mhat, f32x16& negm, float& alpha, bool first) {
    float a = max3f(p0[0], p0[1], p1[0]), b = max3f(p0[2], p0[3], p1[1]); a = max3f(a, p1[2], p1[3]);
#pragma unroll
    for (int r = 4; r < 16; r += 4) { a = max3f(a, p0[r], p0[r + 1]); b = max3f(b, p0[r + 2], p0[r + 3]); a = max3f(a, p1[r], p1[r + 1]); b = max3f(b, p1[r + 2], p1[r + 3]); }
    float rm = max3f(a, b, b);
    { auto rr = __builtin_amdgcn_permlane32_swap(__float_as_uint(rm), __float_as_uint(rm), false, false);
      const float r0 = __uint_as_float(rr[0]), r1 = __uint_as_float(rr[1]); rm = max3f(r0, r1, r1); }
    alpha = 1.f;
    if (__builtin_expect(first || __any(rm > THR), 0)) {
        const float dl = first ? rm : fmaxf(rm, 0.f);
        mhat += dl;
#pragma unroll
        for (int r = 0; r < 16; ++r) { p0[r] -= dl; p1[r] -= dl; }
#pragma unroll
        for (int r = 0; r < 16; ++r) negm[r] = -mhat;
        alpha = __builtin_amdgcn_exp2f(-dl);
    }
#pragma unroll
    for (int r = 0; r < 16; ++r) p0[r] = __builtin_amdgcn_exp2f(p0[r]);
}
__device__ __forceinline__ void finishSM(f32x16& p0, f32x16& p1, bf16x8& pa0, bf16x8& pa1, bf16x8& pa2, bf16x8& pa3) {
#pragma unroll
    for (int r = 0; r < 16; ++r) p1[r] = __builtin_amdgcn_exp2f(p1[r]);
#define PK4(P, BASE, OUT) do { unsigned a0 = cvtpk(P[BASE + 0], P[BASE + 1]), a1 = cvtpk(P[BASE + 2], P[BASE + 3]);   \
    unsigned b0 = cvtpk(P[BASE + 4], P[BASE + 5]), b1 = cvtpk(P[BASE + 6], P[BASE + 7]);                              \
    u32x4 w = {a0, a1, b0, b1}; OUT = *reinterpret_cast<bf16x8*>(&w); } while (0)
    PK4(p0, 0, pa0); PK4(p0, 8, pa1); PK4(p1, 0, pa2); PK4(p1, 8, pa3);
#undef PK4
}
template <class C> __device__ __forceinline__ void qkt(f32x16& p0, f32x16& p1, const char* Ks, const bf16x8* qr, const f32x16& negm, int r32, int hi) {
#pragma unroll
    for (int d0 = 0; d0 < C::DK / 16; ++d0) { const int cb = (d0 * 16 + hi * 8) * 2;
        const bf16x8 b0 = *reinterpret_cast<const bf16x8*>(Ks + kswz<C::KP>(r32, cb));
        const bf16x8 b1 = *reinterpret_cast<const bf16x8*>(Ks + kswz<C::KP>(32 + r32, cb));
        if (d0 == 0) { p0 = __builtin_amdgcn_mfma_f32_32x32x16_bf16(b0, qr[0], negm, 0, 0, 0); p1 = __builtin_amdgcn_mfma_f32_32x32x16_bf16(b1, qr[0], negm, 0, 0, 0); }
        else { p0 = __builtin_amdgcn_mfma_f32_32x32x16_bf16(b0, qr[d0], p0, 0, 0, 0); p1 = __builtin_amdgcn_mfma_f32_32x32x16_bf16(b1, qr[d0], p1, 0, 0, 0); } }
}
template <int NCG> __device__ __forceinline__ int v_st(int k, int c) { const int kk = (k & ~0xC) | ((k & 4) << 1) | ((k & 8) >> 1); return ((kk >> 3) * NCG + (c >> 5)) * 512 + ((kk & 7) * 32 + (c & 31)) * 2; }
__device__ __forceinline__ int v_rd_base(int lane) { return ((lane & 3) << 3) | (((lane >> 2) & 3) << 6) | (((lane >> 4) & 1) << 5) | (((lane >> 5) & 1) << 8); }
template <int NCG> constexpr int v_rd_off(int d0, int ks, int half) { return ((2 * ks + half) * NCG + d0) * 512; }
typedef __attribute__((address_space(3))) const char* lds_cptr;
typedef short v4i16_t __attribute__((ext_vector_type(4)));
__device__ __forceinline__ s16x4 vtr(lds_cptr p) { return __builtin_bit_cast(s16x4, __builtin_amdgcn_ds_read_tr16_b64_v4i16((__attribute__((address_space(3))) v4i16_t*)p)); }
template <int NCG, int D0> __device__ __forceinline__ void pv_one(f32x16& od, lds_cptr vp, bf16x8 pa0, bf16x8 pa1, bf16x8 pa2, bf16x8 pa3) {
    const s16x4 l0 = vtr(vp + v_rd_off<NCG>(D0, 0, 0)), h0 = vtr(vp + v_rd_off<NCG>(D0, 0, 1)), l1 = vtr(vp + v_rd_off<NCG>(D0, 1, 0)), h1 = vtr(vp + v_rd_off<NCG>(D0, 1, 1));
    const s16x4 l2 = vtr(vp + v_rd_off<NCG>(D0, 2, 0)), h2 = vtr(vp + v_rd_off<NCG>(D0, 2, 1)), l3 = vtr(vp + v_rd_off<NCG>(D0, 3, 0)), h3 = vtr(vp + v_rd_off<NCG>(D0, 3, 1));
#define PK(L, H) (bf16x8){L[0], L[1], L[2], L[3], H[0], H[1], H[2], H[3]}
    od = __builtin_amdgcn_mfma_f32_32x32x16_bf16(pa0, PK(l0, h0), od, 0, 0, 0);
    od = __builtin_amdgcn_mfma_f32_32x32x16_bf16(pa1, PK(l1, h1), od, 0, 0, 0);
    od = __builtin_amdgcn_mfma_f32_32x32x16_bf16(pa2, PK(l2, h2), od, 0, 0, 0);
    od = __builtin_amdgcn_mfma_f32_32x32x16_bf16(pa3, PK(l3, h3), od, 0, 0, 0);
#undef PK
}

struct Args {
    const bf16* Q; int ldq;
    const bf16* K1A; const bf16* K1B; int ldk1A, ldk1B;
    const bf16* K2A; const bf16* K2B;
    const bf16* VA; const bf16* VB; int ldvA, ldvB;
    int nA, NT;
    void* O; int ldo;
    const float* rope; int t0;
    const float* rpb; int r0; int kr_lo;
    int comb; float lam, post; const float* ng; bf16* Of; int ldof;
};
__device__ __forceinline__ void glds16(const void* gsrc, unsigned lds_dst) { unsigned keep;
    asm volatile("s_mov_b32 %0, m0\n\ts_mov_b32 m0, %2\n\ts_nop 0\n\tglobal_load_lds_dwordx4 %1, off\n\ts_mov_b32 m0, %0" : "=&s"(keep) : "v"(gsrc), "s"(lds_dst) : "memory"); }
template <class C> __device__ __forceinline__ void attn_unit(const Args& a, char* lds) {
    constexpr int DK = C::DK, DK1 = C::DK1, DV = C::DV, KP = C::KP, NCG = DV / 32;
    constexpr int SHM_V = 64 * DV * 2, SHM_K = 64 * KP, SLOT = SHM_V + SHM_K, RING = 4;
    constexpr int KCH = SHM_K / 8192, VCH = SHM_V / 8192, NDMA = KCH + VCH;
    int tid = threadIdx.x; asm volatile("" : "+v"(tid));
    const int wid = __builtin_amdgcn_readfirstlane(tid >> 6), lane = tid & 63, r32 = lane & 31, hi = lane >> 5;
    float* wsf = (float*)(lds + RING * SLOT) + wid * 64; float* al_l = wsf + 32;
    float* rpb_l = (float*)(lds + RING * SLOT + NWAVES * 256);
    constexpr float Cs = C::SCALE * 1.4426950408889634f;
    float mhat = 0.f; f32x16 negm = f32x16{}; bool first = true; f32x16 o[NCG]; f32x16 ol = f32x16{}; bf16x8 qr[DK / 16];
#pragma unroll
    for (int d = 0; d < NCG; ++d) o[d] = f32x16{};
    __syncthreads();
    if constexpr (C::NAWIN) { for (int i = tid; i < 15 * 32; i += 512) { const int dr = i >> 5, dc = i & 31; rpb_l[i] = (dc < 31) ? a.rpb[dr * 31 + dc] * 1.4426950408889634f : 0.f; } }
    int krow[KCH], kcol[KCH]; bool kval[KCH]; int vrow[VCH], vcol[VCH];
#pragma unroll
    for (int k = 0; k < KCH; ++k) { const int off = ((k * 8 + wid) * 64 + lane) * 16; const int row = off / KP, cbp = off % KP;
        const int swz = (KP == 256) ? ((row & 15) << 4) : (((row >> 1) & 7) << 4); const int col = (cbp ^ swz) >> 1;
        krow[k] = row; kval[k] = col < DK; kcol[k] = kval[k] ? col : 0; }
#pragma unroll
    for (int k = 0; k < VCH; ++k) { const int off = ((k * 8 + wid) * 64 + lane) * 16; const int sub = off >> 9, kkh = sub / NCG, cg = sub % NCG, within = (off & 511) >> 1;
        const int kk = kkh * 8 + (within >> 5); const int key = kk;
        vrow[k] = key; vcol[k] = cg * 32 + (within & 31); }
    const unsigned lds0 = (unsigned)(uintptr_t)lds;
#define ATT_DMA(j_) do { const int jt_ = (j_); const bool sb_ = jt_ >= a.nA; const int jj_ = sb_ ? jt_ - a.nA : jt_;                                    \
        const bf16* k1_ = (sb_ ? a.K1B : a.K1A) + (size_t)jj_ * 64 * (sb_ ? a.ldk1B : a.ldk1A); const int l1_ = sb_ ? a.ldk1B : a.ldk1A;                  \
        const bf16* k2_ = (sb_ ? a.K2B : a.K2A) + (size_t)jj_ * 64 * 32;                                                                                  \
        const bf16* v_ = (sb_ ? a.VB : a.VA) + (size_t)jj_ * 64 * (sb_ ? a.ldvB : a.ldvA); const int lv_ = sb_ ? a.ldvB : a.ldvA;                         \
        const unsigned sl_ = lds0 + (unsigned)((jt_ & (RING - 1)) * SLOT);                                                                                 \
        _Pragma("unroll") for (int k_ = 0; k_ < VCH; ++k_)                                                                                                \
            glds16(v_ + vrow[k_] * lv_ + vcol[k_], (unsigned)__builtin_amdgcn_readfirstlane(sl_ + (k_ * 8 + wid) * 1024));                                 \
        _Pragma("unroll") for (int k_ = 0; k_ < KCH; ++k_) { {                                                                                            \
            const bf16* src_ = (DK1 == DK || kcol[k_] < DK1) ? k1_ + krow[k_] * l1_ + kcol[k_] : k2_ + krow[k_] * 32 + (kcol[k_] - DK1);                   \
            glds16(src_, (unsigned)__builtin_amdgcn_readfirstlane(sl_ + SHM_V + (k_ * 8 + wid) * 1024)); } } } while (0)
    const int NT = a.NT;
    ATT_DMA(0); if (1 < NT) ATT_DMA(1);
    const bf16* Qw = a.Q + (size_t)(wid * 32 + r32) * a.ldq + hi * 8;
#pragma unroll
    for (int d0 = 0; d0 < DK / 16; ++d0) qr[d0] = *reinterpret_cast<const bf16x8*>(Qw + d0 * 16);
    if constexpr (C::QROPE) {
        if (a.rope) {
            const float* rp = a.rope + (size_t)(a.t0 + wid * 32 + r32) * 32 + hi * 8;
            bf16x8 x1 = qr[4], x2 = qr[5], y1, y2;
            const f32x4 c0 = *(const f32x4*)rp, c1 = *(const f32x4*)(rp + 4), s0 = *(const f32x4*)(rp + 16), s1 = *(const f32x4*)(rp + 20);
            const float csv[8] = {c0.x, c0.y, c0.z, c0.w, c1.x, c1.y, c1.z, c1.w}, snv[8] = {s0.x, s0.y, s0.z, s0.w, s1.x, s1.y, s1.z, s1.w};
#pragma unroll
            for (int e = 0; e < 8; ++e) { const float cs = csv[e], sn = snv[e]; const float u1 = bf1((bf16)x1[e]), u2 = bf1((bf16)x2[e]);
                y1[e] = (short)f2bf(u1 * cs - u2 * sn); y2[e] = (short)f2bf(u2 * cs + u1 * sn); }
            qr[4] = y1; qr[5] = y2;
        }
    }
#pragma unroll
    for (int d0 = 0; d0 < DK / 16; ++d0) { bf16x8 x = qr[d0], y;
#pragma unroll
        for (int e = 0; e < 8; ++e) y[e] = (short)f2bf(bf1((bf16)x[e]) * Cs);
        qr[d0] = y; }
    asm volatile("s_waitcnt vmcnt(0)" ::: "memory");
    const lds_cptr vp0 = (lds_cptr)lds + v_rd_base(lane);
    int rq = 0, st_w = 0, qc = 0, cs_w = 0;
    if constexpr (C::NAWIN) { rq = a.r0 + (wid >> 1); st_w = min(max(rq - 4, 0), 56); qc = (wid & 1) * 32 + r32; cs_w = min(max(qc - 8, 0), 48); }
#define ATT_ACTIVE(i_) (!C::NAWIN || (i_) >= a.nA || ((a.kr_lo + (i_)) >= st_w && (a.kr_lo + (i_)) < st_w + 8))
    if (wid >= 4) __builtin_amdgcn_s_setprio(1);
    if constexpr (C::NAWIN) {
    f32x16 pp0 = f32x16{}, pp1 = f32x16{}; bool act_p = false;
#pragma unroll 2
    for (int i = 0; i <= NT; ++i) {
        if (i + 1 < NT) asm volatile("s_waitcnt vmcnt(%0) lgkmcnt(0)\n\ts_barrier" :: "n"(NDMA) : "memory");
        else asm volatile("s_waitcnt vmcnt(0) lgkmcnt(0)\n\ts_barrier" ::: "memory");
        if (i + 2 < NT) ATT_DMA(i + 2);
        const bool act = (i < NT) && ATT_ACTIVE(i);
        f32x16 pc0 = f32x16{}, pc1 = f32x16{}; float alpha = 1.f; bf16x8 pa0, pa1, pa2, pa3;
        SBAR();
        if (act) qkt<C>(pc0, pc1, lds + (i & (RING - 1)) * SLOT + SHM_V, qr, negm, r32, hi);
        if (act_p) finishSM(pp0, pp1, pa0, pa1, pa2, pa3);
        SBAR();
        if (act_p) { const lds_cptr vp = vp0 + ((i - 1) & (RING - 1)) * SLOT;
            pv_one<NCG, 0>(o[0], vp, pa0, pa1, pa2, pa3); pv_one<NCG, 1>(o[1], vp, pa0, pa1, pa2, pa3);
            if constexpr (NCG == 4) { pv_one<NCG, 2>(o[2], vp, pa0, pa1, pa2, pa3); pv_one<NCG, 3>(o[3], vp, pa0, pa1, pa2, pa3); }
            { const bf16x8 ones = {(short)0x3F80, (short)0x3F80, (short)0x3F80, (short)0x3F80, (short)0x3F80, (short)0x3F80, (short)0x3F80, (short)0x3F80};
              ol = __builtin_amdgcn_mfma_f32_32x32x16_bf16(pa0, ones, ol, 0, 0, 0); ol = __builtin_amdgcn_mfma_f32_32x32x16_bf16(pa1, ones, ol, 0, 0, 0);
              ol = __builtin_amdgcn_mfma_f32_32x32x16_bf16(pa2, ones, ol, 0, 0, 0); ol = __builtin_amdgcn_mfma_f32_32x32x16_bf16(pa3, ones, ol, 0, 0, 0); } }
        if (act) {
            if constexpr (C::NAWIN) {
                if (i < a.nA) {
                    const int kr = a.kr_lo + i; const int dr = kr - rq + 7;
#pragma unroll
                    for (int r = 0; r < 16; ++r) { const int kc0 = crow(r, hi), kc1 = kc0 + 32;
                        const bool v0 = (kc0 >= cs_w) && (kc0 < cs_w + 16), v1 = (kc1 >= cs_w) && (kc1 < cs_w + 16);
                        const float b0 = rpb_l[v0 ? dr * 32 + (kc0 - qc + 15) : 0], b1 = rpb_l[v1 ? dr * 32 + (kc1 - qc + 15) : 0];
                        pc0[r] = v0 ? pc0[r] + b0 : -1e30f; pc1[r] = v1 ? pc1[r] + b1 : -1e30f; }
                }
            }
            partialSM(pc0, pc1, mhat, negm, alpha, first);
            if (!first && __any(alpha != 1.f)) { if (hi == 0) al_l[r32] = alpha; asm volatile("s_waitcnt lgkmcnt(0)" ::: "memory");
#pragma unroll
                for (int r = 0; r < 16; ++r) { const float al = al_l[crow(r, hi)]; ol[r] *= al;
#pragma unroll
                    for (int d = 0; d < NCG; ++d) o[d][r] *= al; } }
            first = false;
        }
        pp0 = pc0; pp1 = pc1; act_p = act;
    }
    } else {
        constexpr int ND = DK / 16, EXPF = (ND == 6) ? 16 : 8, NPX = 32 - EXPF, PXR = NPX / NCG, KPF = (NCG == 4) ? 1 : 2;
        static_assert(NPX % NCG == 0, "exp split");
#define ATT_MF(a_, b_, c_) __builtin_amdgcn_mfma_f32_32x32x16_bf16((a_), (b_), (c_), 0, 0, 0)
#define ATT_KLD(Ks_, d0_, h_) (*reinterpret_cast<const bf16x8*>((Ks_) + kswz<KP>((h_) * 32 + r32, ((d0_) * 16 + hi * 8) * 2)))
#define ATT_VRD(dst_, vp_, D0_) do { _Pragma("unroll") for (int ks_ = 0; ks_ < 4; ++ks_) { dst_[2 * ks_] = vtr((vp_) + v_rd_off<NCG>(D0_, ks_, 0)); dst_[2 * ks_ + 1] = vtr((vp_) + v_rd_off<NCG>(D0_, ks_, 1)); } } while (0)
#define ATT_PKV(L, H) (bf16x8){L[0], L[1], L[2], L[3], H[0], H[1], H[2], H[3]}
#define ATT_VMM(od_, v_) do { od_ = ATT_MF(pa0, ATT_PKV(v_[0], v_[1]), od_); od_ = ATT_MF(pa1, ATT_PKV(v_[2], v_[3]), od_); od_ = ATT_MF(pa2, ATT_PKV(v_[4], v_[5]), od_); od_ = ATT_MF(pa3, ATT_PKV(v_[6], v_[7]), od_); } while (0)
#define ATT_ONES() do { const bf16x8 ones = {(short)0x3F80, (short)0x3F80, (short)0x3F80, (short)0x3F80, (short)0x3F80, (short)0x3F80, (short)0x3F80, (short)0x3F80};     \
            ol = ATT_MF(pa0, ones, ol); ol = ATT_MF(pa1, ones, ol); ol = ATT_MF(pa2, ones, ol); ol = ATT_MF(pa3, ones, ol); } while (0)
#define ATT_PK4(P, BASE, OUT) do { unsigned a0 = cvtpk(P[BASE + 0], P[BASE + 1]), a1 = cvtpk(P[BASE + 2], P[BASE + 3]);   \
            unsigned b0 = cvtpk(P[BASE + 4], P[BASE + 5]), b1 = cvtpk(P[BASE + 6], P[BASE + 7]);                              \
            u32x4 w = {a0, a1, b0, b1}; OUT = *reinterpret_cast<bf16x8*>(&w); } while (0)
#define ATT_PX(p0_, p1_, x_) do { float t_ = __builtin_amdgcn_exp2f(((x_) < 16) ? p0_[(x_) & 15] : p1_[((x_) - 16) & 15]); asm volatile("" : "+v"(t_));     \
            if ((x_) < 16) p0_[(x_) & 15] = t_; else p1_[((x_) - 16) & 15] = t_; } while (0)
        f32x16 pp0, pp1; float alpha = 1.f;
        if (1 < NT) asm volatile("s_waitcnt vmcnt(%0) lgkmcnt(0)\n\ts_barrier" :: "n"(NDMA) : "memory");
        else asm volatile("s_waitcnt vmcnt(0) lgkmcnt(0)\n\ts_barrier" ::: "memory");
        if (2 < NT) ATT_DMA(2);
        SBAR();
        qkt<C>(pp0, pp1, lds + SHM_V, qr, negm, r32, hi);
        partialSM(pp0, pp1, mhat, negm, alpha, true);
#pragma unroll
        for (int x = 16; x < NPX; ++x) ATT_PX(pp0, pp1, x);
        SBAR();
        const bf16* pvp[VCH]; const bf16* pkp[KCH]; size_t svb = 0, skb[KCH];
#define ATT_PTR_INIT(j_) do { const int jq_ = (j_); const bool sb_ = jq_ >= a.nA; const int jj_ = sb_ ? jq_ - a.nA : jq_;                                          \
            const bf16* k1_ = (sb_ ? a.K1B : a.K1A) + (size_t)jj_ * 64 * (sb_ ? a.ldk1B : a.ldk1A); const int l1_ = sb_ ? a.ldk1B : a.ldk1A;                       \
            const bf16* k2_ = (sb_ ? a.K2B : a.K2A) + (size_t)jj_ * 64 * 32;                                                                                       \
            const bf16* v_ = (sb_ ? a.VB : a.VA) + (size_t)jj_ * 64 * (sb_ ? a.ldvB : a.ldvA); const int lv_ = sb_ ? a.ldvB : a.ldvA;                              \
            _Pragma("unroll") for (int k_ = 0; k_ < VCH; ++k_) pvp[k_] = v_ + vrow[k_] * lv_ + vcol[k_];                                                           \
            svb = (size_t)64 * lv_;                                                                                                                                \
            _Pragma("unroll") for (int k_ = 0; k_ < KCH; ++k_) { const bool n1_ = (DK1 == DK || kcol[k_] < DK1);                                                   \
                pkp[k_] = n1_ ? k1_ + krow[k_] * l1_ + kcol[k_] : k2_ + krow[k_] * 32 + (kcol[k_] - DK1); skb[k_] = n1_ ? (size_t)64 * l1_ : (size_t)64 * 32; } } while (0)
        ATT_PTR_INIT(3);
#pragma unroll 2
        for (int i = 1; i < NT; ++i) {
            if (i + 1 < NT) asm volatile("s_waitcnt vmcnt(%0) lgkmcnt(0)\n\ts_barrier" :: "n"(NDMA) : "memory");
            else asm volatile("s_waitcnt vmcnt(0) lgkmcnt(0)\n\ts_barrier" ::: "memory");
            const bool dma_on = i + 2 < NT;
            const int jt_ = i + 2;
            if (jt_ == a.nA) ATT_PTR_INIT(jt_);
            const unsigned sl_ = lds0 + (unsigned)((jt_ & (RING - 1)) * SLOT);
#define ATT_PIECE_V(k_) do { if (dma_on) glds16(pvp[k_], (unsigned)__builtin_amdgcn_readfirstlane(sl_ + ((k_) * 8 + wid) * 1024)); pvp[k_] += svb; } while (0)
#define ATT_PIECE_K(k_) do { if (dma_on) glds16(pkp[k_], (unsigned)__builtin_amdgcn_readfirstlane(sl_ + SHM_V + ((k_) * 8 + wid) * 1024)); pkp[k_] += skb[k_]; } while (0)
            static_assert((VCH == 1 && KCH <= 2) || (VCH == 2 && KCH == 1), "piece placement");
            f32x16 pc0, pc1; bf16x8 pa0, pa1, pa2, pa3; bf16x8 ka[ND], kb[ND]; s16x4 va[8], vb[8];
            const char* Ks = lds + (i & (RING - 1)) * SLOT + SHM_V; const lds_cptr vp = vp0 + ((i - 1) & (RING - 1)) * SLOT;
            SBAR();
#pragma unroll
            for (int d0 = 0; d0 < KPF; ++d0) { ka[d0] = ATT_KLD(Ks, d0, 0); kb[d0] = ATT_KLD(Ks, d0, 1); }
            SBAR();
#pragma unroll
            for (int d0 = 0; d0 < ND; ++d0) {
                if (d0 + KPF < ND) { ka[d0 + KPF] = ATT_KLD(Ks, d0 + KPF, 0); kb[d0 + KPF] = ATT_KLD(Ks, d0 + KPF, 1); }
                if constexpr (NCG == 2) { if (d0 == ND - 1) ATT_VRD(va, vp, 0); }
                if (d0 == 0) { pc0 = ATT_MF(ka[0], qr[0], negm); pc1 = ATT_MF(kb[0], qr[0], negm); }
                else { pc0 = ATT_MF(ka[d0], qr[d0], pc0); pc1 = ATT_MF(kb[d0], qr[d0], pc1); }
#pragma unroll
                for (int e = (16 - EXPF) + (d0 * EXPF) / ND; e < (16 - EXPF) + ((d0 + 1) * EXPF) / ND; ++e) pp1[e] = __builtin_amdgcn_exp2f(pp1[e]);
                if (d0 == 0) ATT_PIECE_V(0);
                if constexpr (VCH == 2) { if (d0 == 1) ATT_PIECE_V(1); if (d0 == 2) ATT_PIECE_K(0); }
                else { if (d0 == 1) ATT_PIECE_K(0); if constexpr (KCH == 2) { if (d0 == 3) ATT_PIECE_K(1); } }
                if (d0 == 0) ATT_PK4(pp0, 0, pa0);
                if (d0 == 1) ATT_PK4(pp0, 8, pa1);
                if (d0 == ND / 2) ATT_PK4(pp1, 0, pa2);
                if (d0 == ND - 1) ATT_PK4(pp1, 8, pa3);
                SBAR();
            }
            if constexpr (NCG == 4) ATT_VRD(va, vp, 0);
            ATT_VRD(vb, vp, 1);
            ATT_VMM(o[0], va);
            float rm;
            { float a = max3f(pc0[0], pc0[1], pc1[0]), b = max3f(pc0[2], pc0[3], pc1[1]); a = max3f(a, pc1[2], pc1[3]);
#pragma unroll
              for (int r = 4; r < 16; r += 4) { a = max3f(a, pc0[r], pc0[r + 1]); b = max3f(b, pc0[r + 2], pc0[r + 3]); a = max3f(a, pc1[r], pc1[r + 1]); b = max3f(b, pc1[r + 2], pc1[r + 3]); }
              rm = max3f(a, b, b);
              auto rr = __builtin_amdgcn_permlane32_swap(__float_as_uint(rm), __float_as_uint(rm), false, false);
              const float r0 = __uint_as_float(rr[0]), r1 = __uint_as_float(rr[1]); rm = max3f(r0, r1, r1); }
            SBAR();
            alpha = 1.f;
            if (__builtin_expect(__any(rm > THR), 0)) {
                const float dl = fmaxf(rm, 0.f);
                mhat += dl;
#pragma unroll
                for (int r = 0; r < 16; ++r) { pc0[r] -= dl; pc1[r] -= dl; }
#pragma unroll
                for (int r = 0; r < 16; ++r) negm[r] = -mhat;
                alpha = __builtin_amdgcn_exp2f(-dl);
            }
            SBAR();
            if constexpr (NCG == 2) {
                ATT_VMM(o[1], vb);
#pragma unroll
                for (int x = 0; x < PXR; ++x) ATT_PX(pc0, pc1, x);
                SBAR();
                ATT_ONES();
#pragma unroll
                for (int x = PXR; x < 2 * PXR; ++x) ATT_PX(pc0, pc1, x);
                SBAR();
            } else {
                ATT_VRD(va, vp, 2);
                ATT_VMM(o[1], vb);
#pragma unroll
                for (int x = 0; x < PXR; ++x) ATT_PX(pc0, pc1, x);
                SBAR();
                ATT_VRD(vb, vp, 3);
                ATT_VMM(o[2], va);
#pragma unroll
                for (int x = PXR; x < 2 * PXR; ++x) ATT_PX(pc0, pc1, x);
                SBAR();
                ATT_VMM(o[3], vb);
#pragma unroll
                for (int x = 2 * PXR; x < 3 * PXR; ++x) ATT_PX(pc0, pc1, x);
                SBAR();
                ATT_ONES();
#pragma unroll
                for (int x = 3 * PXR; x < 4 * PXR; ++x) ATT_PX(pc0, pc1, x);
                SBAR();
            }
            if (__any(alpha != 1.f)) { if (hi == 0) al_l[r32] = alpha; asm volatile("s_waitcnt lgkmcnt(0)" ::: "memory");
#pragma unroll
                for (int r = 0; r < 16; ++r) { const float al = al_l[crow(r, hi)]; ol[r] *= al;
#pragma unroll
                    for (int d = 0; d < NCG; ++d) o[d][r] *= al; } }
            pp0 = pc0; pp1 = pc1;
        }
        { bf16x8 pa0, pa1, pa2, pa3; const lds_cptr vp = vp0 + ((NT - 1) & (RING - 1)) * SLOT;
          SBAR();
#pragma unroll
          for (int e = 16 - EXPF; e < 16; ++e) pp1[e] = __builtin_amdgcn_exp2f(pp1[e]);
          ATT_PK4(pp0, 0, pa0); ATT_PK4(pp0, 8, pa1); ATT_PK4(pp1, 0, pa2); ATT_PK4(pp1, 8, pa3);
          SBAR();
          pv_one<NCG, 0>(o[0], vp, pa0, pa1, pa2, pa3); pv_one<NCG, 1>(o[1], vp, pa0, pa1, pa2, pa3);
          if constexpr (NCG == 4) { pv_one<NCG, 2>(o[2], vp, pa0, pa1, pa2, pa3); pv_one<NCG, 3>(o[3], vp, pa0, pa1, pa2, pa3); }
          ATT_ONES(); }
#undef ATT_MF
#undef ATT_KLD
#undef ATT_VRD
#undef ATT_PKV
#undef ATT_VMM
#undef ATT_ONES
#undef ATT_PK4
#undef ATT_PX
#undef ATT_PIECE_V
#undef ATT_PIECE_K
#undef ATT_PTR_INIT
    }
    __builtin_amdgcn_s_setprio(0);
#undef ATT_ACTIVE
#undef ATT_DMA
    float rli[16];
#pragma unroll
    for (int r = 0; r < 16; ++r) rli[r] = __builtin_amdgcn_rcpf(ol[r]);
    if constexpr (C::OUT_F32) {
        float* Ow = (float*)a.O + (size_t)(wid * 32) * a.ldo;
        if (a.comb == 0) {
#pragma unroll
            for (int r = 0; r < 16; ++r) { const int orow = crow(r, hi);
#pragma unroll
                for (int d0 = 0; d0 < NCG; ++d0) Ow[(size_t)orow * a.ldo + d0 * 32 + r32] = o[d0][r] * rli[r]; }
        } else {
            asm volatile("s_waitcnt vmcnt(0)" ::: "memory");
            bf16* Of = a.Of + (size_t)(wid * 32) * a.ldof;
            float ngv[NCG]; unsigned w1[16][NCG];
#pragma unroll
            for (int d0 = 0; d0 < NCG; ++d0) ngv[d0] = a.ng[d0 * 32 + r32];
#pragma unroll
            for (int r = 0; r < 16; ++r)
#pragma unroll
                for (int d0 = 0; d0 < NCG; ++d0) w1[r][d0] = __hip_atomic_load((unsigned*)(Ow + (size_t)crow(r, hi) * a.ldo + d0 * 32 + r32), __ATOMIC_RELAXED, __HIP_MEMORY_SCOPE_AGENT);
            __builtin_amdgcn_sched_barrier(0);
#pragma unroll
            for (int r = 0; r < 16; ++r) { const int orow = crow(r, hi); float v[NCG]; float ss = 0.f;
#pragma unroll
                for (int d0 = 0; d0 < NCG; ++d0) { v[d0] = __uint_as_float(w1[r][d0]) - a.lam * (o[d0][r] * rli[r]); ss += v[d0] * v[d0]; }
                ss += __shfl_xor(ss, 1); ss += __shfl_xor(ss, 2); ss += __shfl_xor(ss, 4); ss += __shfl_xor(ss, 8); ss += __shfl_xor(ss, 16);
                const float rs = a.post / sqrtf(ss * (1.0f / (32 * NCG)) + 1e-6f);
#pragma unroll
                for (int d0 = 0; d0 < NCG; ++d0) Of[(size_t)orow * a.ldof + d0 * 32 + r32] = f2bf(v[d0] * rs * ngv[d0]); }
        }
    } else {
        bf16* Ow = (bf16*)a.O + (size_t)(wid * 32) * a.ldo;
#pragma unroll
        for (int r = 0; r < 16; ++r) { const int orow = crow(r, hi);
#pragma unroll
            for (int d0 = 0; d0 < NCG; ++d0) Ow[(size_t)orow * a.ldo + d0 * 32 + r32] = f2bf(o[d0][r] * rli[r]); }
    }
}
struct CfgMLA  { static constexpr int DK = 96, DK1 = 64, DV = 64,  KP = 256; static constexpr float SCALE = 0.10206207261596577f; static constexpr bool OUT_F32 = false, NAWIN = false, QROPE = true; };
struct CfgNA   { static constexpr int DK = 64, DK1 = 64, DV = 64,  KP = 128; static constexpr float SCALE = 0.125f; static constexpr bool OUT_F32 = false, NAWIN = false, QROPE = false; };
struct CfgNAW  { static constexpr int DK = 64, DK1 = 64, DV = 64,  KP = 128; static constexpr float SCALE = 0.125f; static constexpr bool OUT_F32 = false, NAWIN = true,  QROPE = false; };
struct CfgDIFF { static constexpr int DK = 64, DK1 = 64, DV = 128, KP = 128; static constexpr float SCALE = 0.125f; static constexpr bool OUT_F32 = true,  NAWIN = false, QROPE = false; };
#undef SBAR
}

#define XB_TMO      128
#define XB_XCNT(j)  (256  + 64 * (j))
#define XB_XSUB(j)  (1280 + 64 * (j))
#define XB_XGEN(j)  (2304 + 64 * (j))
#define XB_TOP      3328
#define XB_TOPGEN   3392
#define XCD_BAR_WORDS 3456
#define XB_SPIN_CAP (1u << 18)
__device__ __forceinline__ unsigned xb_ld(unsigned* p)              { return __hip_atomic_load(p, __ATOMIC_RELAXED, __HIP_MEMORY_SCOPE_AGENT); }
__device__ __forceinline__ unsigned xb_add(unsigned* p, unsigned v) { return __hip_atomic_fetch_add(p, v, __ATOMIC_RELAXED, __HIP_MEMORY_SCOPE_AGENT); }
__device__ __forceinline__ unsigned xb_xcc_id() { return (unsigned)__builtin_amdgcn_s_getreg((3 << 11) | 20) & 0xFu; }
#define XB_SPIN(cond, bar) do { unsigned _sp = 0; while (cond) { __builtin_amdgcn_s_sleep(1); \
    if ((++_sp & 255u) == 0u) { if (xb_ld(&(bar)[XB_TMO])) break; if (_sp > XB_SPIN_CAP) { atomicAdd(&(bar)[XB_TMO], 1u); break; } } } } while (0)
struct XcdBarrier { unsigned* bar; unsigned x; volatile LAS unsigned* st; };
__device__ __forceinline__ XcdBarrier xcd_barrier_post(unsigned* bar, volatile LAS unsigned* st) {
    XcdBarrier b; b.bar = bar; b.x = xb_xcc_id(); b.st = st;
    if (threadIdx.x == 0) (void)xb_add(&bar[XB_XCNT(b.x)], 1u);
    return b;
}
__device__ __forceinline__ void xcd_barrier_complete(unsigned* bar, unsigned x, unsigned& nloc, unsigned& nx) {
    const unsigned G = gridDim.x * gridDim.y * gridDim.z;
    unsigned sum, cnt, mine, sp = 0u;
    for (;;) {
        sum = 0u; cnt = 0u; mine = 0u;
#pragma unroll
        for (unsigned j = 0; j < 16; ++j) { const unsigned c = xb_ld(&bar[XB_XCNT(j)]); sum += c; cnt += (c > 0u) ? 1u : 0u; mine = (j == x) ? c : mine; }
        if (sum == G) break;
        __builtin_amdgcn_s_sleep(1);
        if ((++sp & 255u) == 0u) { if (xb_ld(&bar[XB_TMO])) break; if (sp > XB_SPIN_CAP) { atomicAdd(&bar[XB_TMO], 1u); break; } }
    }
    nloc = mine > 0u ? mine : 1u; nx = cnt > 0u ? cnt : 1u;
}
__device__ __forceinline__ void xcd_barrier(const XcdBarrier& b) {
    asm volatile("s_waitcnt vmcnt(0)" ::: "memory");
    __syncthreads();
    if (threadIdx.x == 0) {
        unsigned* bar = b.bar;
        __builtin_amdgcn_s_waitcnt(0);
        unsigned nloc = b.st[0], nx = b.st[1];
        if (nloc == 0u) { xcd_barrier_complete(bar, b.x, nloc, nx); b.st[0] = nloc; b.st[1] = nx; }
        const unsigned old = xb_add(&bar[XB_XSUB(b.x)], 1u);
        const unsigned gen = old / nloc;
        if (old + 1u == (gen + 1u) * nloc) {
            __builtin_amdgcn_fence(__ATOMIC_RELEASE, "agent");
            asm volatile("s_waitcnt vmcnt(0)" ::: "memory");
            const unsigned og = xb_add(&bar[XB_TOP], 1u);
            const unsigned tg = og / nx;
            if (og + 1u == (tg + 1u) * nx) xb_add(&bar[XB_TOPGEN], 1u);
            else XB_SPIN(xb_ld(&bar[XB_TOPGEN]) == tg, bar);
            __builtin_amdgcn_fence(__ATOMIC_ACQUIRE, "agent");
            xb_add(&bar[XB_XGEN(b.x)], 1u);
            asm volatile("s_waitcnt vmcnt(0)" ::: "memory");
        } else {
            XB_SPIN(xb_ld(&bar[XB_XGEN(b.x)]) == gen, bar);
            __builtin_amdgcn_fence(__ATOMIC_ACQUIRE, "agent");
            asm volatile("s_waitcnt vmcnt(0)" ::: "memory");
        }
    }
    __syncthreads();
}

__device__ __forceinline__ void transpose_item(const float* W, int Nsrc, int src_k0, int src_n0, bf16* WT, int Kdst, int dst_k0, int dst_n0, LAS float* scr, int lane) {
    f32x4 v[8];
    const int kk0 = lane >> 3, n4 = (lane & 7) * 4;
    if (src_n0 >= 0) {
#pragma unroll
        for (int i = 0; i < 8; ++i) v[i] = __builtin_nontemporal_load((const f32x4*)(W + (size_t)(src_k0 + kk0 + 8 * i) * Nsrc + src_n0 + n4));
    } else {
#pragma unroll
        for (int i = 0; i < 8; ++i) v[i] = (f32x4){0.f, 0.f, 0.f, 0.f};
    }
#pragma unroll
    for (int i = 0; i < 8; ++i) { LAS float* d = scr + (kk0 + 8 * i) * 33 + n4; d[0] = v[i].x; d[1] = v[i].y; d[2] = v[i].z; d[3] = v[i].w; }
    LDS_WAIT(); asm volatile("" ::: "memory");
    const int c = lane & 7;
#pragma unroll
    for (int j = 0; j < 4; ++j) { const int n = (lane >> 3) + 8 * j; const LAS float* s = scr + (8 * c) * 33 + n;
        v4u o; o.x = cvt_pk_bf16(s[0 * 33], s[1 * 33]); o.y = cvt_pk_bf16(s[2 * 33], s[3 * 33]); o.z = cvt_pk_bf16(s[4 * 33], s[5 * 33]); o.w = cvt_pk_bf16(s[6 * 33], s[7 * 33]);
        *(GAS v4u*)(WT + (size_t)(dst_n0 + n) * Kdst + dst_k0 + 8 * c) = o; }
    LDS_WAIT(); asm volatile("" ::: "memory");
}

struct KArgs { const float* in[27]; float* out; unsigned char* ws; int ph_lo, ph_hi; };
typedef const __attribute__((address_space(4))) KArgs* KAP;

__device__ __forceinline__ void wconv_layer(KAP P, int L, LAS float* scr, int gw, int NGW, int lane) {
    bf16* WT = (bf16*)(P->ws + WS_WT);
    const float* w_in = P->in[13] + (size_t)L * 2048 * IN_COLS;
    const float* w_uq = P->in[16] + (size_t)L * 512 * 768;
    const float* w_ukv = P->in[17] + (size_t)L * 256 * 1024;
    const float* pool_w = P->in[19] + (size_t)L * 4 * 128 * 128;
    const float* w_br = P->in[23] + (size_t)L * 2048 * 2048;
    const float* w_o = P->in[24] + (size_t)L * 2048 * 2048;
    const float* w_up = P->in[25] + (size_t)L * 2048 * 8192;
    const float* w_dn = P->in[26] + (size_t)L * 8192 * 2048;
    constexpr int I_IN = 32 * 400, I_UQ = 8 * 24, I_UKV = 4 * 32, I_POOL = 8 * 16, I_BR = 32 * 64, I_O = 32 * 64, I_UP = 32 * 256, I_DN = 128 * 64;
    constexpr int NIT = I_IN + I_UQ + I_UKV + I_POOL + I_BR + I_O + I_UP + I_DN;
    for (int it = gw; it < NIT; it += NGW) {
        int r = it;
        if (r < I_IN) { const int kb = r / 400, nb = r % 400, n0 = nb * 32;
            int src = (n0 < 768) ? n0 : (n0 < 4352) ? n0 + 32 : (n0 < 4384) ? n0 - 4352 + 768 : (n0 < 4608) ? -1 : n0 - 224;
            transpose_item(w_in, IN_COLS, kb * 64, src, WT + WT_IN, 2048, kb * 64, n0, scr, lane); continue; } r -= I_IN;
        if (r < I_UQ) { const int kb = r / 24, nb = r % 24; transpose_item(w_uq, 768, kb * 64, nb * 32, WT + WT_UQ, 512, kb * 64, nb * 32, scr, lane); continue; } r -= I_UQ;
        if (r < I_UKV) { const int kb = r / 32, nb = r % 32; transpose_item(w_ukv, 1024, kb * 64, nb * 32, WT + WT_UKV, 256, kb * 64, nb * 32, scr, lane); continue; } r -= I_UKV;
        if (r < I_POOL) { const int kb = r / 16, nb = r % 16; const int gk = (kb * 64) / 128, gn = (nb * 32) / 128;
            if (gk == gn) transpose_item(pool_w + (size_t)gk * 128 * 128, 128, kb * 64 - gk * 128, nb * 32 - gn * 128, WT + WT_POOL, 512, kb * 64, nb * 32, scr, lane);
            else transpose_item(pool_w, 128, 0, -1, WT + WT_POOL, 512, kb * 64, nb * 32, scr, lane);
            continue; } r -= I_POOL;
        if (r < I_BR) { const int kb = r / 64, nb = r % 64; transpose_item(w_br, 2048, kb * 64, nb * 32, WT + WT_BR, 2048, kb * 64, nb * 32, scr, lane); continue; } r -= I_BR;
        if (r < I_O) { const int kb = r / 64, nb = r % 64; transpose_item(w_o, 2048, kb * 64, nb * 32, WT + WT_O, 2048, kb * 64, nb * 32, scr, lane); continue; } r -= I_O;
        if (r < I_UP) { const int kb = r / 256, nb = r % 256; transpose_item(w_up, 8192, kb * 64, nb * 32, WT + WT_UP, 2048, kb * 64, nb * 32, scr, lane); continue; } r -= I_UP;
        { const int kb = r / 64, nb = r % 64; transpose_item(w_dn, 2048, kb * 64, nb * 32, WT + WT_DN, 8192, kb * 64, nb * 32, scr, lane); }
    }
}

__device__ __forceinline__ int cond_of_row(int m) { return m < NCTX ? 4 : ((m - NCTX) >> 12); }

__device__ __forceinline__ void norm_row0(int lane, const float* xin, const float* A, const float* B, bf16* hout) {
    f32x4 xv[8]; float ss = 0.f;
#pragma unroll
    for (int j = 0; j < 8; ++j) { xv[j] = *(const f32x4*)(xin + lane * 4 + 256 * j); ss += (xv[j].x * xv[j].x + xv[j].y * xv[j].y) + (xv[j].z * xv[j].z + xv[j].w * xv[j].w); }
    f32x4 av[8], bv[8];
#pragma unroll
    for (int j = 0; j < 8; ++j) { av[j] = *(const f32x4*)(A + lane * 4 + 256 * j); bv[j] = *(const f32x4*)(B + lane * 4 + 256 * j); }
    __builtin_amdgcn_sched_barrier(0);
    const float rstd = 1.0f / sqrtf(wave_sum(ss) * (1.0f / DM) + RMS_EPS);
#pragma unroll
    for (int j = 0; j < 8; ++j) { const int c = lane * 4 + 256 * j; const f32x4 h = xv[j] * rstd * av[j] + bv[j];
        v2u o; o.x = cvt_pk_bf16(h.x, h.y); o.y = cvt_pk_bf16(h.z, h.w); *(v2u*)(hout + c) = o; }
}
__device__ __forceinline__ void resnorm_phase(int lane, int gw, int NGW, const float* Xa, const float* Xb, float* X, const bf16* YB, const float* dGA, const float* dA, const float* dB, bf16* H, bool store_x) {
    int m = gw; if (m >= MTOK) return;
    f32x4 cx[8]; v2u cy[8];
#pragma unroll
    for (int j = 0; j < 8; ++j) { const float* xr = (m < NCTX) ? Xa + (size_t)m * DM : Xb + (size_t)(m - NCTX) * DM; cx[j] = __builtin_nontemporal_load((const f32x4*)(xr + lane * 4 + 256 * j)); cy[j] = __builtin_nontemporal_load((const v2u*)(YB + (size_t)m * DM + lane * 4 + 256 * j)); }
#pragma unroll 1
    while (m < MTOK) {
        const int mn = m + NGW; f32x4 nx[8]; v2u ny[8];
        if (mn < MTOK) {
#pragma unroll
            for (int j = 0; j < 8; ++j) { const float* xr = (mn < NCTX) ? Xa + (size_t)mn * DM : Xb + (size_t)(mn - NCTX) * DM; nx[j] = __builtin_nontemporal_load((const f32x4*)(xr + lane * 4 + 256 * j)); ny[j] = __builtin_nontemporal_load((const v2u*)(YB + (size_t)mn * DM + lane * 4 + 256 * j)); }
        } else {
#pragma unroll
            for (int j = 0; j < 8; ++j) { nx[j] = (f32x4){0.f, 0.f, 0.f, 0.f}; ny[j] = (v2u){0u, 0u}; }
        }
        const size_t co = (size_t)cond_of_row(m) * 12288 + lane * 4;
        f32x4 ga[8];
#pragma unroll
        for (int j = 0; j < 8; ++j) ga[j] = *(const f32x4*)(dGA + co + 256 * j);
        f32x4 yv[8]; float ss = 0.f;
#pragma unroll
        for (int j = 0; j < 8; ++j) { yv[j] = (f32x4){bflo(cy[j].x), bfhi(cy[j].x), bflo(cy[j].y), bfhi(cy[j].y)}; ss += (yv[j].x * yv[j].x + yv[j].y * yv[j].y) + (yv[j].z * yv[j].z + yv[j].w * yv[j].w); }
        const float rstd = 1.0f / sqrtf(wave_sum(ss) * (1.0f / DM) + RMS_EPS);
        float s2 = 0.f;
#pragma unroll
        for (int j = 0; j < 8; ++j) { cx[j] = cx[j] + ga[j] * (yv[j] * rstd); s2 += (cx[j].x * cx[j].x + cx[j].y * cx[j].y) + (cx[j].z * cx[j].z + cx[j].w * cx[j].w); }
        if (store_x) {
#pragma unroll
            for (int j = 0; j < 8; ++j) *(f32x4*)(X + (size_t)m * DM + lane * 4 + 256 * j) = cx[j];
        }
        if (H) {
            f32x4 av[8], bv[8];
#pragma unroll
            for (int j = 0; j < 8; ++j) { av[j] = *(const f32x4*)(dA + co + 256 * j); bv[j] = *(const f32x4*)(dB + co + 256 * j); }
            __builtin_amdgcn_sched_barrier(0);
            const float r2 = 1.0f / sqrtf(wave_sum(s2) * (1.0f / DM) + RMS_EPS);
#pragma unroll
            for (int j = 0; j < 8; ++j) { const f32x4 h = cx[j] * r2 * av[j] + bv[j];
                v2u o; o.x = cvt_pk_bf16(h.x, h.y); o.y = cvt_pk_bf16(h.z, h.w); *(v2u*)(H + (size_t)m * DM + lane * 4 + 256 * j) = o; }
        }
#pragma unroll
        for (int j = 0; j < 8; ++j) { cx[j] = nx[j]; cy[j] = ny[j]; }
        m = mn;
    }
}

constexpr int PH_PRO = 0, PH_MODSUM = 1, PH_T0 = 2, PH_L0 = 3, PH_PER_LAYER = 11, NPH = PH_L0 + NLAYER * PH_PER_LAYER;

__global__ void __launch_bounds__(NWAVES * 64, 2) trunk_fwd(KArgs args) {
    extern __shared__ __attribute__((aligned(16))) unsigned char lds[];
    LAS unsigned char* ldsL = (LAS unsigned char*)lds;
    volatile LAS unsigned* MISC = (volatile LAS unsigned*)(ldsL + MISC_OFF);
    const int G0 = gridDim.x; const int bx0 = blockIdx.x;
    const KAP kap0 = (KAP)__builtin_amdgcn_kernarg_segment_ptr();
    { gu32* ctl0 = (gu32*)(kap0->ws + WS_CTL); (void)ctl0; }
    for (int u = threadIdx.x; u < (LDS_BYTES - LDSCTL_OFF) / 4; u += NWAVES * 64) ((LAS unsigned*)(ldsL + LDSCTL_OFF))[u] = 0u;
    __syncthreads();
    XcdBarrier bar; bar.bar = (unsigned*)((gu32*)(kap0->ws + WS_CTL) + CW_BAR); bar.x = 0; bar.st = nullptr;
#if !MK_MULTI
    bar = xcd_barrier_post((unsigned*)((gu32*)(kap0->ws + WS_CTL) + CW_BAR), MISC + 8);
#endif
    const int lo = kap0->ph_lo, hi = kap0->ph_hi;
#define IN(k) (lo <= (k) && (k) < hi)
#if MK_MULTI
#define SEAM(k) do { } while (0)
#else
#define SEAM(k) do { if (IN(k) && IN((k) + 1)) xcd_barrier(bar); } while (0)
#endif
#define PHASE_ENV() \
    KAP P = kap0; asm volatile("" : "+s"(P)); unsigned char* ws = P->ws; (void)ws; \
    int G = G0, bx = bx0; asm volatile("" : "+s"(G), "+s"(bx)); const int vcu = (G % 8 == 0) ? (bx % 8) * (G / 8) + bx / 8 : bx; const int NGW = G * NWAVES; (void)vcu; (void)NGW; \
    int tid = threadIdx.x; asm volatile("" : "+v"(tid)); const int lane = tid & 63, wave = __builtin_amdgcn_readfirstlane(tid >> 6); const int gw = vcu * NWAVES + wave; (void)lane; (void)gw; \
    float* X = P->out; float* MOD = (float*)(ws + WS_MOD); float* ROPE_MLA = (float*)(ws + WS_ROPE_MLA); float* ROPE_DIFF = (float*)(ws + WS_ROPE_DIFF); float* MODP = (float*)(ws + WS_MODP); \
    bf16* WT = (bf16*)(ws + WS_WT); bf16* H = (bf16*)(ws + WS_H); bf16* PB = (bf16*)(ws + WS_P); bf16* GT = (bf16*)(ws + WS_GT); bf16* YB = (bf16*)(ws + WS_Y); \
    bf16* QN = (bf16*)(ws + WS_QN); bf16* CKV = (bf16*)(ws + WS_CKV); bf16* KR = (bf16*)(ws + WS_KR); bf16* POOLED = (bf16*)(ws + WS_POOLED); \
    bf16* QM = (bf16*)(ws + WS_QM); bf16* KVX = (bf16*)(ws + WS_KVX); \
    bf16* NAKC = (bf16*)(ws + WS_NAKC); bf16* NAVC = (bf16*)(ws + WS_NAVC); bf16* DKC = (bf16*)(ws + WS_DKC); bf16* DVC = (bf16*)(ws + WS_DVC); \
    float* DO = (float*)(ws + WS_DO); bf16* OALL = (bf16*)(ws + WS_OALL); const float* g_norm = P->in[12]; \
    (void)GT; (void)X; (void)MOD; (void)ROPE_MLA; (void)ROPE_DIFF; (void)MODP; (void)WT; (void)H; (void)PB; (void)YB; (void)QN; (void)CKV; (void)KR; (void)POOLED; (void)QM; (void)KVX; \
    (void)NAKC; (void)NAVC; (void)DKC; (void)DVC; (void)DO; (void)OALL; (void)g_norm;

    if ((PHMASK & 1) && IN(PH_PRO)) { PHASE_ENV();
        LAS float* scr = (LAS float*)(ldsL + wave * 9216);
        LAS float* S = (LAS float*)(ldsL + 73728);
        for (int i = tid; i < 5 * 2048; i += 512) { const int r = i >> 11, k = i & 2047; const float v = (r < 4) ? P->in[8][r * 2048 + k] : P->in[9][k]; S[i] = v / (1.0f + __expf(-v)); }
        __syncthreads();
        for (int it = gw; it < 4 * 48 * 16; it += NGW) {
            const int L = it / (48 * 16), rem = it % (48 * 16), cg = rem / 16, kc = rem % 16; const int n = cg * 256 + lane * 4;
            const float* W = P->in[10] + ((size_t)L * 2048 + kc * 128) * 12288 + n;
            f32x4 a0 = {0, 0, 0, 0}, a1 = a0, a2 = a0, a3 = a0, a4 = a0;
#pragma unroll 8
            for (int k = 0; k < 128; ++k) { const f32x4 w = __builtin_nontemporal_load((const f32x4*)(W + (size_t)k * 12288)); const int kk = kc * 128 + k;
                a0 += w * S[kk]; a1 += w * S[2048 + kk]; a2 += w * S[4096 + kk]; a3 += w * S[6144 + kk]; a4 += w * S[8192 + kk]; }
            float* o = MODP + ((size_t)(L * 16 + kc) * 5) * 12288 + n;
            *(f32x4*)(o) = a0; *(f32x4*)(o + 12288) = a1; *(f32x4*)(o + 2 * 12288) = a2; *(f32x4*)(o + 3 * 12288) = a3; *(f32x4*)(o + 4 * 12288) = a4;
        }
        for (int i = bx * 512 + tid; i < 4096 * 16; i += G * 512) { const int t = i >> 4, a = i & 15; const float pos = (a < 8) ? (float)(t >> 6) : (float)(t & 63);
            const float inv = powf(10000.0f, -(float)(a & 7) / 8.0f); const float ang = pos * inv; ROPE_MLA[t * 32 + a] = cosf(ang); ROPE_MLA[t * 32 + 16 + a] = sinf(ang); }
        for (int i = bx * 512 + tid; i < 4096 * 32; i += G * 512) { const int t = i >> 5, a = i & 31; const float pos = (a < 16) ? (float)(t >> 6) : (float)(t & 63);
            const float inv = powf(10000.0f, -(float)(a & 15) / 16.0f); const float ang = pos * inv; ROPE_DIFF[t * 64 + a] = cosf(ang); ROPE_DIFF[t * 64 + 32 + a] = sinf(ang); }
        wconv_layer(P, 0, scr, gw, NGW, lane);
        __syncthreads();
    }
    SEAM(PH_PRO);
    if ((PHMASK & 2) && IN(PH_MODSUM)) { PHASE_ENV();
        for (int i = bx * 512 + tid; i < 4 * 5 * 6 * 2048; i += G * 512) { const int n = i & 2047, k = (i >> 11) % 6, r = (i / (6 * 2048)) % 5, L = i / (5 * 6 * 2048);
            const int off = (k == 0) ? 4096 : (k == 1) ? 8192 : (k == 2) ? 6144 : (k == 3) ? 10240 : (k == 4) ? 2048 : 0;
            float sm = P->in[11][L * 12288 + off + n];
#pragma unroll
            for (int kc = 0; kc < 16; ++kc) sm += MODP[((size_t)(L * 16 + kc) * 5 + r) * 12288 + off + n];
            const float* gl = g_norm + (size_t)L * 4 * DM;
            const float v = (k == 0) ? sm * gl[DM + n] : (k == 1) ? gl[2 * DM + n] * (1.0f + sm) : (k == 2) ? sm : (k == 3) ? sm * gl[3 * DM + n] : (k == 4) ? gl[n] * (1.0f + sm) : sm;
            MOD[i] = v; }
    }
    SEAM(PH_MODSUM);
    if ((PHMASK & 4) && IN(PH_T0)) { PHASE_ENV();
        for (int m = gw; m < MTOK; m += NGW) {
            const float* xin = (m < NCTX) ? P->in[0] + (size_t)m * DM : P->in[1] + (size_t)(m - NCTX) * DM;
            const float* md = MOD + (size_t)cond_of_row(m) * 12288;
            norm_row0(lane, xin, md + 4 * 2048, md + 5 * 2048, H + (size_t)m * DM);
        }
    }
    SEAM(PH_T0);

    for (int L = 0; L < NLAYER; ++L) {
        const int pb = PH_L0 + L * PH_PER_LAYER;
#define gn (g_norm + (size_t)L * 4 * DM)
#define MODL (MOD + (size_t)L * 5 * 12288)
        if ((PHMASK & 8) && IN(pb + 0)) { PHASE_ENV();
            pg8::Gemm g{H, WT + WT_IN, MTOK, NW_IN, 2048, 2048, 2048}; pg8::StaticOrder S; S.init(MTOK, NW_IN, G, bx);
            pg8::Epi<pg8::EP_G1> E{PB, PW, 0, nullptr, GT, C_GATE / 256, P->out, L};
            for (int rep = 0; rep < REP_G1; ++rep) pg8::gemm_phase<pg8::Epi<pg8::EP_G1>>(ldsL, g, S, E);
        }
        SEAM(pb + 0);
        if ((PHMASK & 16) && IN(pb + 1)) { PHASE_ENV();
            const float* gq = P->in[14] + L * 512; const float* gkv = P->in[15] + L * 256;
            for (int rep = 0; rep < REP_T1; ++rep)
            for (int item = gw; item < MKV; item += NGW) {
                if (item < MTOK) {
                    const int m = item; const bool ctx = m < NCTX; bf16* pr = PB + (size_t)m * PW;
                    int b, p, T, mb; if (ctx) { b = m >> 8; p = m & 255; T = 256; mb = b * 256; } else { const int mm = m - NCTX; b = mm >> 12; p = mm & 4095; T = 4096; mb = NCTX + b * 4096; }
                    const size_t so = ((size_t)(b * 4 + L) * 256 + p);
                    const v4u wq = *(const v4u*)(pr + C_QC + lane * 8);
                    const v2u wkv = *(const v2u*)(pr + C_KVC + lane * 4);
                    const bf16 kr1 = pr[C_KR + (lane & 15)], kr2 = pr[C_KR + 16 + (lane & 15)];
                    const int blk = lane >> 3, i0 = (lane & 7) * 4;
                    v2u wqa = {0u, 0u}, wqb = wqa, wka = wqa, wkb = wqa; f32x4 rcs = {0.f, 0.f, 0.f, 0.f}, rsn = rcs; float mcs = 1.f, msn = 0.f;
                    if (!ctx) { wqa = *(const v2u*)(pr + C_DQ + blk * 64 + i0); wqb = *(const v2u*)(pr + C_DQ + blk * 64 + 32 + i0);
                                wka = *(const v2u*)(pr + C_DK + blk * 64 + i0); wkb = *(const v2u*)(pr + C_DK + blk * 64 + 32 + i0);
                                rcs = *(const f32x4*)(ROPE_DIFF + (size_t)p * 64 + i0); rsn = *(const f32x4*)(ROPE_DIFF + (size_t)p * 64 + 32 + i0);
                                mcs = ROPE_MLA[p * 32 + (lane & 15)]; msn = ROPE_MLA[p * 32 + 16 + (lane & 15)]; }
                    const int g = lane >> 4, half = 1 << g; const int lo_ = max(p - half, 0), hi_ = min(p + half, T);
                    v4u wp[16];
#pragma unroll
                    for (int d = 0; d < 16; ++d) { const int q = p + d - 8; const int qq = min(max(q, lo_), hi_ - 1);
                        wp[d] = *(const v4u*)(PB + (size_t)(mb + qq) * PW + C_POOL + lane * 8); }
                    __builtin_amdgcn_sched_barrier(0);
                    const f32x4 gq0 = *(const f32x4*)(gq + lane * 8), gq1 = *(const f32x4*)(gq + lane * 8 + 4), gk0 = *(const f32x4*)(gkv + lane * 4);
                    { float x[8] = {bflo(wq.x), bfhi(wq.x), bflo(wq.y), bfhi(wq.y), bflo(wq.z), bfhi(wq.z), bflo(wq.w), bfhi(wq.w)};
                      float ss = 0.f;
#pragma unroll
                      for (int e = 0; e < 8; ++e) ss += x[e] * x[e];
                      const float rstd = 1.0f / sqrtf(wave_sum(ss) * (1.0f / 512) + RMS_EPS);
                      v4u o; o.x = cvt_pk_bf16(x[0] * rstd * gq0.x, x[1] * rstd * gq0.y); o.y = cvt_pk_bf16(x[2] * rstd * gq0.z, x[3] * rstd * gq0.w);
                      o.z = cvt_pk_bf16(x[4] * rstd * gq1.x, x[5] * rstd * gq1.y); o.w = cvt_pk_bf16(x[6] * rstd * gq1.z, x[7] * rstd * gq1.w);
                      *(v4u*)(QN + (size_t)m * 512 + lane * 8) = o; }
                    { float x[4] = {bflo(wkv.x), bfhi(wkv.x), bflo(wkv.y), bfhi(wkv.y)};
                      const float ss = (x[0] * x[0] + x[1] * x[1]) + (x[2] * x[2] + x[3] * x[3]);
                      const float rstd = 1.0f / sqrtf(wave_sum(ss) * (1.0f / 256) + RMS_EPS);
                      const f32x4 v = {x[0] * rstd * gk0.x, x[1] * rstd * gk0.y, x[2] * rstd * gk0.z, x[3] * rstd * gk0.w};
                      v2u o; o.x = cvt_pk_bf16(v.x, v.y); o.y = cvt_pk_bf16(v.z, v.w);
                      *(v2u*)(CKV + (size_t)m * 256 + lane * 4) = o;
                      if (ctx) *(f32x4*)(P->out + OUT_CKV + so * 256 + lane * 4) = v; }
                    if (lane < 16) { const float x1 = bf1(kr1), x2 = bf1(kr2);
                      KR[(size_t)m * 32 + lane] = f2bf(x1 * mcs - x2 * msn); KR[(size_t)m * 32 + 16 + lane] = f2bf(x2 * mcs + x1 * msn); }
                    if (!ctx) {
#pragma unroll
                        for (int q = 0; q < 2; ++q) { bf16* base = pr + (q == 0 ? C_DQ : C_DK) + blk * 64 + i0; const v2u wa = q == 0 ? wqa : wka, wb = q == 0 ? wqb : wkb;
                            const f32x4 xa = {bflo(wa.x), bfhi(wa.x), bflo(wa.y), bfhi(wa.y)}, xb = {bflo(wb.x), bfhi(wb.x), bflo(wb.y), bfhi(wb.y)};
                            const f32x4 ya = xa * rcs - xb * rsn, yb = xb * rcs + xa * rsn;
                            v2u oa, ob2; oa.x = cvt_pk_bf16(ya.x, ya.y); oa.y = cvt_pk_bf16(ya.z, ya.w); ob2.x = cvt_pk_bf16(yb.x, yb.y); ob2.y = cvt_pk_bf16(yb.z, yb.w);
                            if (rep == REP_T1 - 1) { *(v2u*)base = oa; *(v2u*)(base + 32) = ob2; } }
                    }
                    { float acc8[8] = {0, 0, 0, 0, 0, 0, 0, 0};
#pragma unroll
                      for (int d = 0; d < 16; ++d) { const int q = p + d - 8; v4u w = wp[d]; if (!(q >= lo_ && q < hi_)) w = (v4u){0u, 0u, 0u, 0u};
                          acc8[0] += bflo(w.x); acc8[1] += bfhi(w.x); acc8[2] += bflo(w.y); acc8[3] += bfhi(w.y); acc8[4] += bflo(w.z); acc8[5] += bfhi(w.z); acc8[6] += bflo(w.w); acc8[7] += bfhi(w.w); }
                      const v4u ws_ = wp[8]; const float self[8] = {bflo(ws_.x), bfhi(ws_.x), bflo(ws_.y), bfhi(ws_.y), bflo(ws_.z), bfhi(ws_.z), bflo(ws_.w), bfhi(ws_.w)};
                      const float rc = 1.0f / (float)(hi_ - lo_);
                      v4u o; o.x = cvt_pk_bf16(acc8[0] * rc - self[0], acc8[1] * rc - self[1]); o.y = cvt_pk_bf16(acc8[2] * rc - self[2], acc8[3] * rc - self[3]);
                      o.z = cvt_pk_bf16(acc8[4] * rc - self[4], acc8[5] * rc - self[5]); o.w = cvt_pk_bf16(acc8[6] * rc - self[6], acc8[7] * rc - self[7]);
                      *(v4u*)(POOLED + (size_t)m * 512 + lane * 8) = o; }
                } else {
                    const int j = item - MTOK, b = j >> 9, jj = j & 511; const size_t cr = (size_t)(b * 4 + L) * 512 + jj;
                    { const f32x4 v = *(const f32x4*)(P->in[2] + cr * 256 + lane * 4); v2u o; o.x = cvt_pk_bf16(v.x, v.y); o.y = cvt_pk_bf16(v.z, v.w); *(v2u*)(CKV + (size_t)item * 256 + lane * 4) = o; }
                    if (lane < 32) KR[(size_t)item * 32 + lane] = f2bf(P->in[3][cr * 32 + lane]);
                    { f32x4 c0[4], c1[4];
#pragma unroll
                      for (int q = 0; q < 4; ++q) { const float* src = P->in[4 + q] + cr * 512 + lane * 8; c0[q] = *(const f32x4*)src; c1[q] = *(const f32x4*)(src + 4); }
                      __builtin_amdgcn_sched_barrier(0);
#pragma unroll
                      for (int q = 0; q < 4; ++q) { bf16* dst = ((q == 0) ? NAKC : (q == 1) ? NAVC : (q == 2) ? DKC : DVC) + (size_t)j * 512 + lane * 8;
                        v4u o; o.x = cvt_pk_bf16(c0[q].x, c0[q].y); o.y = cvt_pk_bf16(c0[q].z, c0[q].w); o.z = cvt_pk_bf16(c1[q].x, c1[q].y); o.w = cvt_pk_bf16(c1[q].z, c1[q].w); *(v4u*)dst = o; } }
                }
            }
        }
        SEAM(pb + 1);
        if ((PHMASK & 32) && IN(pb + 2)) { PHASE_ENV();
            _Pragma("unroll 1") for (int rep = 0; rep < REP_G2; ++rep) {
            { pg8::Gemm g{QN, WT + WT_UQ, MTOK, 768, 512, 512, 512}; pg8::StaticOrder S; S.init(MTOK, 768, G, bx);
              pg8::Epi<pg8::EP_BF16> E{QM, 768, 0, nullptr, nullptr, 0, nullptr, 0}; pg8::gemm_phase<pg8::Epi<pg8::EP_BF16>>(ldsL, g, S, E); }
            { pg8::Gemm g{CKV, WT + WT_UKV, MKV, 1024, 256, 256, 256}; pg8::StaticOrder S; S.init(MKV, 1024, G, bx);
              pg8::Epi<pg8::EP_BF16> E{KVX, 1024, 0, nullptr, nullptr, 0, nullptr, 0}; pg8::gemm_phase<pg8::Epi<pg8::EP_BF16>>(ldsL, g, S, E); }
            { pg8::Gemm g{POOLED, WT + WT_POOL, MTOK, 512, 512, 512, 512}; pg8::StaticOrder S; S.init(MTOK, 512, G, bx);
              pg8::Epi<pg8::EP_POOL> E{OALL, 2048, 1024, P->in[20] + L * 512, nullptr, 0, nullptr, 0}; pg8::gemm_phase<pg8::Epi<pg8::EP_POOL>>(ldsL, g, S, E); }
            }
        }
        SEAM(pb + 2);
        if ((PHMASK & 64) && IN(pb + 3)) { PHASE_ENV();
            char* al = (char*)lds;
            for (int rep = 0; rep < REP_A1; ++rep) {
            if (ATTMASK & 1)
            _Pragma("unroll 1") for (int rp_ = 0; rp_ < 1 + ((ATTREP >> 0) & 1); ++rp_)
            for (int u = vcu; u < 256; u += G) { const int b = u >> 3, h = u & 7; const size_t m0 = (size_t)b * 256;
                att::Args a{}; a.Q = QM + m0 * 768 + h * 96; a.ldq = 768;
                a.K1A = KVX + m0 * 1024 + h * 128; a.K1B = a.K1A; a.ldk1A = 1024; a.ldk1B = 1024; a.K2A = KR + m0 * 32; a.K2B = a.K2A;
                a.VA = KVX + m0 * 1024 + h * 128 + 64; a.VB = a.VA; a.ldvA = 1024; a.ldvB = 1024; a.nA = 4; a.NT = 4;
                a.O = OALL + m0 * 2048 + h * 64; a.ldo = 2048; a.rope = nullptr; a.t0 = 0; a.rpb = nullptr; a.r0 = 0; a.kr_lo = 0;
                att::attn_unit<att::CfgMLA>(a, al); }
            if (ATTMASK & 2)
            _Pragma("unroll 1") for (int rp_ = 0; rp_ < 1 + ((ATTREP >> 1) & 1); ++rp_)
            for (int u = vcu; u < 512; u += G) { const int qb = u & 15, h = (u >> 4) & 7, b = u >> 7; const size_t mb = NCTX + (size_t)b * 4096, m0 = mb + qb * 256; const size_t cb = MTOK + (size_t)b * 512;
                att::Args a{}; a.Q = QM + m0 * 768 + h * 96; a.ldq = 768;
                a.K1A = KVX + mb * 1024 + h * 128; a.K1B = KVX + cb * 1024 + h * 128; a.ldk1A = 1024; a.ldk1B = 1024; a.K2A = KR + mb * 32; a.K2B = KR + cb * 32;
                a.VA = KVX + mb * 1024 + h * 128 + 64; a.VB = KVX + cb * 1024 + h * 128 + 64; a.ldvA = 1024; a.ldvB = 1024; a.nA = 64; a.NT = 72;
                a.O = OALL + m0 * 2048 + h * 64; a.ldo = 2048; a.rope = ROPE_MLA; a.t0 = qb * 256; a.rpb = nullptr; a.r0 = 0; a.kr_lo = 0;
                att::attn_unit<att::CfgMLA>(a, al); }
            if (ATTMASK & 4)
            _Pragma("unroll 1") for (int rp_ = 0; rp_ < 1 + ((ATTREP >> 2) & 1); ++rp_)
            for (int u = vcu; u < 256; u += G) { const int b = u >> 3, h = u & 7; const size_t m0 = (size_t)b * 256;
                att::Args a{}; a.Q = PB + m0 * PW + C_NAQ + h * 64; a.ldq = PW;
                a.K1A = PB + m0 * PW + C_NAK + h * 64; a.K1B = a.K1A; a.ldk1A = PW; a.ldk1B = PW; a.K2A = nullptr; a.K2B = nullptr;
                a.VA = PB + m0 * PW + C_NAV + h * 64; a.VB = a.VA; a.ldvA = PW; a.ldvB = PW; a.nA = 4; a.NT = 4;
                a.O = OALL + m0 * 2048 + 512 + h * 64; a.ldo = 2048; a.rope = nullptr; a.t0 = 0; a.rpb = nullptr; a.r0 = 0; a.kr_lo = 0;
                att::attn_unit<att::CfgNA>(a, al); }
            if (ATTMASK & 8)
            _Pragma("unroll 1") for (int rp_ = 0; rp_ < 1 + ((ATTREP >> 3) & 1); ++rp_)
            for (int u = vcu; u < 512; u += G) { const int rg = u & 15, h = (u >> 4) & 7, b = u >> 7; const size_t mb = NCTX + (size_t)b * 4096; const int r0 = rg * 4;
                const int kr_lo = min(max(r0 - 4, 0), 56), kr_hi = min(max(r0 + 3 - 4, 0), 56) + 8; const size_t m0 = mb + (size_t)r0 * 64;
                att::Args a{}; a.Q = PB + m0 * PW + C_NAQ + h * 64; a.ldq = PW;
                a.K1A = PB + (mb + (size_t)kr_lo * 64) * PW + C_NAK + h * 64; a.ldk1A = PW; a.K1B = NAKC + (size_t)b * 512 * 512 + h * 64; a.ldk1B = 512; a.K2A = nullptr; a.K2B = nullptr;
                a.VA = PB + (mb + (size_t)kr_lo * 64) * PW + C_NAV + h * 64; a.ldvA = PW; a.VB = NAVC + (size_t)b * 512 * 512 + h * 64; a.ldvB = 512;
                a.nA = kr_hi - kr_lo; a.NT = a.nA + 8;
                a.O = OALL + m0 * 2048 + 512 + h * 64; a.ldo = 2048; a.rope = nullptr; a.t0 = 0;
                a.rpb = P->in[18] + ((size_t)L * 8 + h) * 15 * 31; a.r0 = r0; a.kr_lo = kr_lo;
                att::attn_unit<att::CfgNAW>(a, al); }
            const float* lp = P->in[21] + L * 256; const float lam_init = 0.8f - 0.6f * expf(-0.3f * (float)L);
            const float lam = expf(wave_sum(lp[lane] * lp[64 + lane])) - expf(wave_sum(lp[128 + lane] * lp[192 + lane])) + lam_init;
            if (ATTMASK & 16)
            _Pragma("unroll 1") for (int rp_ = 0; rp_ < 1 + ((ATTREP >> 4) & 1); ++rp_)
            for (int u = vcu; u < 128; u += G) { const int b = u >> 2, h = u & 3; const size_t m0 = (size_t)b * 256;
                _Pragma("unroll 1") for (int mp = 0; mp < 2; ++mp) {
                att::Args a{}; a.Q = PB + m0 * PW + C_DQ + h * 128 + mp * 64; a.ldq = PW;
                a.K1A = PB + m0 * PW + C_DK + h * 128 + mp * 64; a.K1B = a.K1A; a.ldk1A = PW; a.ldk1B = PW; a.K2A = nullptr; a.K2B = nullptr;
                a.VA = PB + m0 * PW + C_DV + h * 128; a.VB = a.VA; a.ldvA = PW; a.ldvB = PW; a.nA = 4; a.NT = 4;
                a.O = DO + m0 * 512 + h * 128; a.ldo = 512; a.rope = nullptr; a.t0 = 0; a.rpb = nullptr; a.r0 = 0; a.kr_lo = 0;
                a.comb = mp; a.lam = lam; a.post = 1.0f - lam_init; a.ng = P->in[22] + L * 128; a.Of = OALL + m0 * 2048 + 1536 + h * 128; a.ldof = 2048;
                att::attn_unit<att::CfgDIFF>(a, al); } }
            if (ATTMASK & 32)
            _Pragma("unroll 1") for (int rp_ = 0; rp_ < 1 + ((ATTREP >> 5) & 1); ++rp_)
            for (int u = vcu; u < 256; u += G) { const int qb = u & 15, h = (u >> 4) & 3, b = u >> 6; const size_t mb = NCTX + (size_t)b * 4096, m0 = mb + qb * 256;
                _Pragma("unroll 1") for (int mp = 0; mp < 2; ++mp) {
                att::Args a{}; a.Q = PB + m0 * PW + C_DQ + h * 128 + mp * 64; a.ldq = PW;
                a.K1A = PB + mb * PW + C_DK + h * 128 + mp * 64; a.ldk1A = PW; a.K1B = DKC + (size_t)b * 512 * 512 + h * 128 + mp * 64; a.ldk1B = 512; a.K2A = nullptr; a.K2B = nullptr;
                a.VA = PB + mb * PW + C_DV + h * 128; a.ldvA = PW; a.VB = DVC + (size_t)b * 512 * 512 + h * 128; a.ldvB = 512; a.nA = 64; a.NT = 72;
                a.O = DO + m0 * 512 + h * 128; a.ldo = 512; a.rope = nullptr; a.t0 = 0; a.rpb = nullptr; a.r0 = 0; a.kr_lo = 0;
                a.comb = mp; a.lam = lam; a.post = 1.0f - lam_init; a.ng = P->in[22] + L * 128; a.Of = OALL + m0 * 2048 + 1536 + h * 128; a.ldof = 2048;
                att::attn_unit<att::CfgDIFF>(a, al); } }
            }
            __syncthreads();
        }
#if !MK_MULTI
        if (IN(pb + 3) && IN(pb + 5)) xcd_barrier(bar);
#endif
        if ((PHMASK & 256) && IN(pb + 5)) { PHASE_ENV();
            pg8::Gemm g{OALL, WT + WT_BR, MTOK, 2048, 2048, 2048, 2048}; pg8::StaticOrder S; S.init(MTOK, 2048, G, bx);
            pg8::Epi<pg8::EP_MERGE> E{H, 2048, 0, nullptr, GT, 0, nullptr, 0};
            _Pragma("unroll 1") for (int rep = 0; rep < REP_G3; ++rep) pg8::gemm_phase<pg8::Epi<pg8::EP_MERGE>>(ldsL, g, S, E);
        }
        SEAM(pb + 5);
        if ((PHMASK & 512) && IN(pb + 6)) { PHASE_ENV();
            pg8::Gemm g{H, WT + WT_O, MTOK, 2048, 2048, 2048, 2048}; pg8::StaticOrder S; S.init(MTOK, 2048, G, bx);
            pg8::Epi<pg8::EP_BF16> E{YB, 2048, 0, nullptr, nullptr, 0, nullptr, 0};
            _Pragma("unroll 1") for (int rep = 0; rep < REP_G4; ++rep) pg8::gemm_phase<pg8::Epi<pg8::EP_BF16>>(ldsL, g, S, E);
        }
        SEAM(pb + 6);
        if ((PHMASK & 1024) && IN(pb + 7)) { PHASE_ENV();
            _Pragma("unroll 1") for (int rep = 0; rep < REP_T23; ++rep)
                resnorm_phase(lane, gw, NGW, (L == 0) ? P->in[0] : X, (L == 0) ? P->in[1] : X + (size_t)NCTX * DM, X, YB, MODL, MODL + 2048, MODL + 2 * 2048, H, rep == REP_T23 - 1);
        }
        SEAM(pb + 7);
        if ((PHMASK & 2048) && IN(pb + 8)) { PHASE_ENV();
            pg8::Gemm g{H, WT + WT_UP, MTOK, FF, 2048, 2048, 2048}; pg8::StaticOrder S; S.init(MTOK, FF, G, bx);
            pg8::Epi<pg8::EP_RELU2> E{GT, FF, 0, nullptr, nullptr, 0, nullptr, 0};
            _Pragma("unroll 1") for (int rep = 0; rep < REP_G56; ++rep) pg8::gemm_phase<pg8::Epi<pg8::EP_RELU2>>(ldsL, g, S, E);
        }
        SEAM(pb + 8);
        if ((PHMASK & 4096) && IN(pb + 9)) { PHASE_ENV();
            pg8::Gemm g{GT, WT + WT_DN, MTOK, 2048, FF, FF, FF}; pg8::StaticOrder S; S.init(MTOK, 2048, G, bx);
            pg8::Epi<pg8::EP_BF16> E{YB, 2048, 0, nullptr, nullptr, 0, nullptr, 0};
            _Pragma("unroll 1") for (int rep = 0; rep < REP_G56; ++rep) pg8::gemm_phase<pg8::Epi<pg8::EP_BF16>>(ldsL, g, S, E);
        }
        SEAM(pb + 9);
        if ((PHMASK & 8192) && IN(pb + 10)) { PHASE_ENV();
            const bool more = (L + 1 < NLAYER);
            const float* MODN = MOD + (size_t)(more ? L + 1 : L) * 5 * 12288;
            _Pragma("unroll 1") for (int rep = 0; rep < REP_T23; ++rep)
                resnorm_phase(lane, gw, NGW, X, X + (size_t)NCTX * DM, X, YB, MODL + 3 * 2048, MODN + 4 * 2048, MODN + 5 * 2048, more ? H : nullptr, rep == REP_T23 - 1);
            if (more) { LAS float* scr = (LAS float*)(ldsL + wave * 9216); wconv_layer(P, L + 1, scr, gw, NGW, lane); }
        }
        SEAM(pb + 10);
    }
#undef gn
#undef MODL
#undef IN
#undef SEAM
}

extern "C" void kernel_launch(void* const* d_in, const int* in_sizes, int n_in, void* d_out, int out_size, void* d_ws, size_t ws_size, hipStream_t stream) {
    static int grid = 0;
    if (grid == 0) {
        if (n_in != 27 || (size_t)out_size != OUT_END || ws_size < WS_END) { fprintf(stderr, "kernel_launch: shape mismatch n_in %d out %d ws %zu (need %zu)\n", n_in, out_size, ws_size, (size_t)WS_END); grid = -1; return; }
        int dev = 0, cus = 0, per_cu = 0;
        if (hipGetDevice(&dev) != hipSuccess || hipDeviceGetAttribute(&cus, hipDeviceAttributeMultiprocessorCount, dev) != hipSuccess) { grid = -1; return; }
        if (hipFuncSetAttribute((const void*)trunk_fwd, hipFuncAttributeMaxDynamicSharedMemorySize, LDS_BYTES) != hipSuccess) { fprintf(stderr, "kernel_launch: hipFuncSetAttribute failed\n"); grid = -1; return; }
        if (hipOccupancyMaxActiveBlocksPerMultiprocessor(&per_cu, (const void*)trunk_fwd, NWAVES * 64, LDS_BYTES) != hipSuccess || per_cu < 1)
            fprintf(stderr, "kernel_launch: occupancy query reports %d\n", per_cu);
        (void)hipGetLastError();
        grid = cus;
    }
    if (grid < 0) return;
    if (hipMemsetAsync((char*)d_ws + WS_CTL, 0, CTL_ZERO_BYTES, stream) != hipSuccess) return;
    KArgs a{};
    for (int i = 0; i < 27; ++i) a.in[i] = (const float*)d_in[i];
    a.out = (float*)d_out; a.ws = (unsigned char*)d_ws;
#if MK_MULTI
    for (int ph = 0; ph < NPH; ++ph) { a.ph_lo = ph; a.ph_hi = ph + 1; hipLaunchKernelGGL(trunk_fwd, dim3(grid), dim3(NWAVES * 64), LDS_BYTES, stream, a); }
#else
    a.ph_lo = 0; a.ph_hi = NPH;
    hipLaunchKernelGGL(trunk_fwd, dim3(grid), dim3(NWAVES * 64), LDS_BYTES, stream, a);
#endif
    const hipError_t le = hipPeekAtLastError();
    if (le != hipSuccess) fprintf(stderr, "kernel_launch: launch failed: %s\n", hipGetErrorName(le));
}
```

```cpp
#include <hip/hip_runtime.h>
#include <cstdio>
#include <cstdint>

#ifndef REP_T23
#define REP_T23 1
#endif
#ifndef REP_G2
#define REP_G2 1
#endif
#ifndef REP_G3
#define REP_G3 1
#endif
#ifndef REP_G4
#define REP_G4 1
#endif
#ifndef REP_G56
#define REP_G56 1
#endif
#ifndef REP_T1
#define REP_T1 1
#endif
#ifndef REP_A1
#define REP_A1 1
#endif
#ifndef REP_G1
#define REP_G1 1
#endif
#ifndef ATTREP
#define ATTREP 0
#endif
#ifndef ATTMASK
#define ATTMASK 63
#endif
#ifndef PHMASK
#define PHMASK 0xFFFFF
#endif
#ifndef MK_MULTI
#define MK_MULTI 0
#endif

#define GAS __attribute__((address_space(1)))
#define LAS __attribute__((address_space(3)))
typedef unsigned short bf16;
typedef unsigned v4u __attribute__((ext_vector_type(4)));
typedef unsigned v2u __attribute__((ext_vector_type(2)));
typedef float f32x4 __attribute__((ext_vector_type(4)));
typedef float f32x2 __attribute__((ext_vector_type(2)));
typedef GAS unsigned gu32;
#define RLX_AGENT __ATOMIC_RELAXED, __HIP_MEMORY_SCOPE_AGENT
#define LDS_WAIT() asm volatile("s_waitcnt lgkmcnt(0)" ::: "memory")
#define VM_WAIT() asm volatile("s_waitcnt vmcnt(0)" ::: "memory")

constexpr int DM = 2048, NCTX = 8192, MTOK = 24576, MKV = 26624, NLAYER = 4, LSEQ = 4096, CSEQ = 256, PAST = 512, FF = 8192;
constexpr int PW = 4608;
constexpr int NW_IN = 12800;
constexpr int C_QC = 0, C_KVC = 512, C_NAQ = 768, C_NAK = 1280, C_NAV = 1792, C_POOL = 2304, C_DQ = 2816, C_DK = 3328, C_DV = 3840, C_KR = 4352, C_GATE = 4608;
constexpr int IN_COLS = 12576;
constexpr float RMS_EPS = 1e-6f;
constexpr size_t OUT_X = 0, OUT_CKV = 50331648, OUT_KROPE = 58720256, OUT_NAK = 59768832, OUT_NAV = 76546048, OUT_DK = 93323264, OUT_DV = 110100480, OUT_END = 126877696;

constexpr size_t MiB = 1u << 20;
constexpr size_t WS_CTL = 0, CTL_ZERO_BYTES = 1 * MiB;
constexpr size_t WS_MOD = 1 * MiB;
constexpr size_t WS_ROPE_MLA = 2 * MiB;
constexpr size_t WS_ROPE_DIFF = 2 * MiB + 512 * 1024;
constexpr size_t WS_MODP = 4 * MiB;
constexpr size_t WS_WT = 20 * MiB;
constexpr size_t WT_IN = 0, WT_UQ = WT_IN + (size_t)12800 * 2048, WT_UKV = WT_UQ + (size_t)768 * 512, WT_POOL = WT_UKV + (size_t)1024 * 256,
                 WT_BR = WT_POOL + (size_t)512 * 512, WT_O = WT_BR + (size_t)2048 * 2048, WT_UP = WT_O + (size_t)2048 * 2048, WT_DN = WT_UP + (size_t)8192 * 2048,
                 WT_END = WT_DN + (size_t)2048 * 8192;
static_assert(WT_END * 2 <= 132 * MiB, "weights fit");
constexpr size_t WS_H = 152 * MiB;
constexpr size_t WS_P = 248 * MiB;
constexpr size_t WS_GT = 464 * MiB;
constexpr size_t WS_MID = 848 * MiB;
constexpr size_t WS_Y = WS_MID;
constexpr size_t WS_QN = WS_MID + 0 * MiB;
constexpr size_t WS_CKV = WS_MID + 24 * MiB;
constexpr size_t WS_KR = WS_MID + 37 * MiB;
constexpr size_t WS_POOLED = WS_MID + 39 * MiB;
constexpr size_t WS_QM = WS_MID + 63 * MiB;
constexpr size_t WS_KVX = WS_MID + 99 * MiB;
constexpr size_t WS_NAKC = WS_MID + 151 * MiB, WS_NAVC = WS_MID + 153 * MiB, WS_DKC = WS_MID + 155 * MiB, WS_DVC = WS_MID + 157 * MiB;
constexpr size_t WS_DO = WS_MID + 159 * MiB;
constexpr size_t WS_OALL = WS_MID + 255 * MiB;
constexpr size_t WS_END = WS_MID + 351 * MiB;

constexpr int CW_TMO = 0, CW_BAR = 4096;

constexpr int RING_BYTES = 131072, LDSCTL_OFF = RING_BYTES, MISC_OFF = LDSCTL_OFF + 320, LDS_BYTES = 147456;
constexpr int NWAVES = 8;

__device__ __forceinline__ unsigned cvt_pk_bf16(float lo, float hi) { unsigned r; asm volatile("v_cvt_pk_bf16_f32 %0, %1, %2" : "=v"(r) : "v"(lo), "v"(hi)); return r; }
__device__ __forceinline__ float bflo(unsigned w) { return __uint_as_float(w << 16); }
__device__ __forceinline__ float bfhi(unsigned w) { return __uint_as_float(w & 0xffff0000u); }
__device__ __forceinline__ float bf1(bf16 v) { return __uint_as_float(((unsigned)v) << 16); }
__device__ __forceinline__ bf16 f2bf(float f) { return (bf16)(cvt_pk_bf16(f, 0.f) & 0xffffu); }
__device__ __forceinline__ float wave_sum(float v) {
#pragma unroll
    for (int o = 1; o < 64; o <<= 1) v += __shfl_xor(v, o);
    return v;
}

namespace pg8 {
#define PG8_LAS __attribute__((address_space(3)))
typedef unsigned short bf16_t;
typedef short bf16x8 __attribute__((ext_vector_type(8)));
typedef unsigned u32x4 __attribute__((ext_vector_type(4)));
constexpr int BM = 256, BK = 64, HALF = 128, HTB = HALF * BK * 2, STAGE_BYTES = 8 * HTB, NXCD = 8, WGM = 8;

__host__ __device__ __forceinline__ int lds_byte(int r, int c) { const int st = (r >> 4) * 2 + (c >> 5), rr = r & 15, cc = c & 31, ob = rr * 64 + cc * 2; return st * 1024 + (ob ^ (((ob >> 9) & 1) << 5)); }
__host__ __device__ __forceinline__ void stage_rc(int b, int& R, int& C) { const int st = b / 1024, sb = b % 1024, swz = sb ^ (((sb >> 9) & 1) << 5); R = (st >> 1) * 16 + swz / 64; C = (st & 1) * 32 + (swz % 64) / 2; }
__host__ __device__ __forceinline__ int perm32(int rho) { const int n = rho >> 4, i = rho & 15; return 8 * (i >> 2) + 4 * n + (i & 3); }

struct Unit { int pm, pn; };
struct Gemm { const bf16_t* A; const bf16_t* Bt; int M, N, K, lda, ldb; };

struct StaticOrder {
    int nM, nN, nwg, G, c;
    __host__ __device__ void init(int M, int N, int G_, int c_) { nM = M / BM; nN = N / BM; nwg = nM * nN; G = G_; c = c_; }
    __host__ __device__ bool next(int i, Unit& u) const {
        const long L = (long)i * G + c; if (L >= nwg) return false;
        int wgid = (int)L; { const int q = nwg / NXCD, r = nwg % NXCD, xcd = wgid % NXCD, off = wgid / NXCD; wgid = (xcd < r ? xcd * (q + 1) : r * (q + 1) + (xcd - r) * q) + off; }
        const int nig = WGM * nN, gid = wgid / nig, fm = gid * WGM, gsz = (nM - fm) < WGM ? (nM - fm) : WGM;
        u.pm = fm + ((wgid % nig) % gsz); u.pn = (wgid % nig) / gsz; return true;
    }
};

enum { EP_BF16 = 0, EP_G1 = 1, EP_RELU2 = 2, EP_F32 = 3, EP_POOL = 4, EP_MERGE = 5 };
template <int MODE> struct Epi {
    static constexpr bool PERM = true, MIDK = (MODE == EP_MERGE);
    void* O; int ldc; int col_off;
    const float* aux;
    bf16_t* gates;
    int sig_pn;
    float* state; int layer;
    __device__ __forceinline__ void operator()(f32x4 (&acc)[2][2][4][2], const Unit& u, int wr, int wc, int fr, int fq) const {
        const int row0 = u.pm * BM + wr * 64 + fr; const int colt = u.pn * BM + wc * 32 + 8 * fq;
        const int lidx = ((wr * 4 + wc) * 64 + fq * 16 + fr) * 8;
        const bool sig = (MODE == EP_G1) && (u.pn >= sig_pn);
        float* st = nullptr; int st_pitch = 512;
        if (MODE == EP_G1) { if (u.pm < 32) { const int pn = u.pn; size_t ob = 0; int c0 = -1;
            if (pn == 5 || pn == 6) { ob = OUT_NAK; c0 = (pn - 5) * 256; } else if (pn == 7 || pn == 8) { ob = OUT_NAV; c0 = (pn - 7) * 256; }
            else if (pn == 13 || pn == 14) { ob = OUT_DK; c0 = (pn - 13) * 256; } else if (pn == 15 || pn == 16) { ob = OUT_DV; c0 = (pn - 15) * 256; }
            else if (pn == 17) { ob = OUT_KROPE; c0 = 0; st_pitch = 32; }
            if (c0 >= 0) st = state + ob + (size_t)(u.pm * 4 + layer) * 256 * st_pitch + c0 + wc * 32 + 8 * fq; } }
        f32x4 sc[2][2];
        if (MODE == EP_POOL) {
#pragma unroll
            for (int bj = 0; bj < 2; ++bj)
#pragma unroll
                for (int n = 0; n < 2; ++n) sc[bj][n] = *(const f32x4*)(aux + colt + bj * HALF + 4 * n);
        }
        bf16_t* gt = nullptr;
        if (MODE == EP_G1) gt = gates + ((size_t)u.pm * 32 + (u.pn - sig_pn)) * 65536 + lidx;
        u32x4 gfin[2][4][2];
        if (MODE == EP_MERGE) { gt = gates + ((size_t)u.pm * 32 + 24 + u.pn) * 65536 + lidx;
#pragma unroll
            for (int ai = 0; ai < 2; ++ai)
#pragma unroll
                for (int m = 0; m < 4; ++m)
#pragma unroll
                    for (int bj = 0; bj < 2; ++bj) gfin[ai][m][bj] = __builtin_nontemporal_load((const u32x4*)(gt + ((ai * 4 + m) * 2 + bj) * 4096));
            __builtin_amdgcn_sched_barrier(0); }
#pragma unroll
        for (int ai = 0; ai < 2; ++ai)
#pragma unroll
            for (int m = 0; m < 4; ++m) {
                const int rit = wr * 64 + fr + ai * HALF + m * 16;
                const size_t row = (size_t)(u.pm * BM + rit);
#pragma unroll
                for (int bj = 0; bj < 2; ++bj) {
                    f32x4 v0 = acc[ai][bj][m][0], v1 = acc[ai][bj][m][1];
                    const int col = colt + bj * HALF;
                    const int gidx = ((ai * 4 + m) * 2 + bj) * 4096;
                    if (MODE == EP_G1) {
                        if (sig) {
#pragma unroll
                            for (int e = 0; e < 4; ++e) { v0[e] = fminf(1.f + __builtin_amdgcn_exp2f(-1.4426950408889634f * v0[e]), 1e30f);
                                                          v1[e] = fminf(1.f + __builtin_amdgcn_exp2f(-1.4426950408889634f * v1[e]), 1e30f); }
                            u32x4 w; w.x = cvt_pk_bf16(v0[0], v0[1]); w.y = cvt_pk_bf16(v0[2], v0[3]); w.z = cvt_pk_bf16(v1[0], v1[1]); w.w = cvt_pk_bf16(v1[2], v1[3]);
                            __builtin_nontemporal_store(w, (u32x4*)(gt + gidx));
                            continue;
                        }
                        if (st) { if (st_pitch == 512 || (bj == 0 && wc == 0)) { float* p = st + (size_t)rit * st_pitch + bj * HALF; *(f32x4*)p = v0; *(f32x4*)(p + 4) = v1; } }
                    }
                    if (MODE == EP_RELU2) {
#pragma unroll
                        for (int e = 0; e < 4; ++e) { const float a = fmaxf(v0[e], 0.f), b = fmaxf(v1[e], 0.f); v0[e] = a * a; v1[e] = b * b; } }
                    if (MODE == EP_POOL) { v0 = v0 * sc[bj][0]; v1 = v1 * sc[bj][1]; }
                    if (MODE == EP_MERGE) {
                        const u32x4 g = gfin[ai][m][bj];
                        v0[0] *= __builtin_amdgcn_rcpf(bflo(g.x)); v0[1] *= __builtin_amdgcn_rcpf(bfhi(g.x)); v0[2] *= __builtin_amdgcn_rcpf(bflo(g.y)); v0[3] *= __builtin_amdgcn_rcpf(bfhi(g.y));
                        v1[0] *= __builtin_amdgcn_rcpf(bflo(g.z)); v1[1] *= __builtin_amdgcn_rcpf(bfhi(g.z)); v1[2] *= __builtin_amdgcn_rcpf(bflo(g.w)); v1[3] *= __builtin_amdgcn_rcpf(bfhi(g.w));
                    }
                    if (MODE == EP_F32) {
                        float* p = (float*)O + row * ldc + col_off + col;
                        *(f32x4*)p = v0; *(f32x4*)(p + 4) = v1;
                    } else {
                        u32x4 w; w.x = cvt_pk_bf16(v0[0], v0[1]); w.y = cvt_pk_bf16(v0[2], v0[3]); w.z = cvt_pk_bf16(v1[0], v1[1]); w.w = cvt_pk_bf16(v1[2], v1[3]);
                        *(u32x4*)((bf16_t*)O + row * ldc + col_off + col) = w;
                    }
                }
            }
    }
    __device__ __forceinline__ void midk(f32x4 (&acc)[2][2][4][2], const Unit& u, int seg, int wr, int wc, int fr, int fq) const {
        const unsigned loff = (unsigned)(((wr * 4 + wc) * 64 + fq * 16 + fr) * 8) * 2u;
        const bf16_t* ta = gates + ((size_t)u.pm * 32 + (seg - 1) * 8 + u.pn) * 65536;
        const bf16_t* tb = ta + (size_t)8 * 65536;
#pragma unroll
        for (int ai = 0; ai < 2; ++ai) {
            u32x4 ga[4][2], gb[4][2];
#pragma unroll
            for (int m = 0; m < 4; ++m)
#pragma unroll
                for (int bj = 0; bj < 2; ++bj) { const int gidx = ((ai * 4 + m) * 2 + bj) * 4096; ga[m][bj] = __builtin_nontemporal_load((const u32x4*)((const char*)(ta + gidx) + loff)); gb[m][bj] = __builtin_nontemporal_load((const u32x4*)((const char*)(tb + gidx) + loff)); }
            __builtin_amdgcn_sched_barrier(0);
#pragma unroll
            for (int m = 0; m < 4; ++m)
#pragma unroll
                for (int bj = 0; bj < 2; ++bj) {
                    const u32x4 a = ga[m][bj], b = gb[m][bj];
                    f32x4& v0 = acc[ai][bj][m][0]; f32x4& v1 = acc[ai][bj][m][1];
                    v0[0] *= bflo(b.x) * __builtin_amdgcn_rcpf(bflo(a.x)); v0[1] *= bfhi(b.x) * __builtin_amdgcn_rcpf(bfhi(a.x));
                    v0[2] *= bflo(b.y) * __builtin_amdgcn_rcpf(bflo(a.y)); v0[3] *= bfhi(b.y) * __builtin_amdgcn_rcpf(bfhi(a.y));
                    v1[0] *= bflo(b.z) * __builtin_amdgcn_rcpf(bflo(a.z)); v1[1] *= bfhi(b.z) * __builtin_amdgcn_rcpf(bfhi(a.z));
                    v1[2] *= bflo(b.w) * __builtin_amdgcn_rcpf(bflo(a.w)); v1[3] *= bfhi(b.w) * __builtin_amdgcn_rcpf(bfhi(a.w));
                }
            __builtin_amdgcn_sched_barrier(0);
        }
    }
};

template <class EpiT, bool ALIGN_EPI = true>
__device__ __forceinline__ void gemm_phase(PG8_LAS unsigned char* lds, const Gemm g, const StaticOrder& S, const EpiT& E) {
    int tid = threadIdx.x; asm volatile("" : "+v"(tid));
    const int wid = __builtin_amdgcn_readfirstlane(tid >> 6), lane = tid & 63, wr = wid >> 2, wc = wid & 3, fr = lane & 15, fq = lane >> 4;
    int K = g.K; asm volatile("" : "+s"(K)); const int nt = K / BK;
    unsigned voffA[2], voffB[2];
#pragma unroll
    for (int i = 0; i < 2; ++i) { int R, C; stage_rc(tid * 16 + i * 8192, R, C); const int Rb = EpiT::PERM ? ((R & ~31) + perm32(R & 31)) : R;
        voffA[i] = (unsigned)(R * g.lda + C) * 2u; voffB[i] = (unsigned)(Rb * g.ldb + C) * 2u; }
    const size_t kstep = (size_t)(BK * 2);
    const size_t hstepA = (size_t)HALF * g.lda * 2, hstepB = (size_t)HALF * g.ldb * 2;
    const size_t tstepA = 2 * hstepA, tstepB = 2 * hstepB;
    const unsigned ldsw = (unsigned)wid * 1024u;
    const unsigned ldsb = (unsigned)__builtin_amdgcn_readfirstlane((int)((unsigned)(uintptr_t)lds + ldsw));
    const int aoff = lds_byte(wr * 64 + fr, fq * 8), boff = lds_byte(wc * 32 + fr, fq * 8);
#define PG8_SA(b, h) (((b) * 2 + (h)) * HTB)
#define PG8_SB(b, h) ((4 + (b) * 2 + (h)) * HTB)
#define PG8_STAGE(bufoff, gbase, voff) do { _Pragma("unroll") for (int _i = 0; _i < 2; ++_i) { unsigned keep_;                              \
        asm volatile("s_mov_b32 %0, m0\n\ts_mov_b32 m0, %3\n\ts_nop 0\n\tglobal_load_lds_dwordx4 %1, %2\n\ts_mov_b32 m0, %0"                        \
                     : "=&s"(keep_) : "v"((voff)[_i]), "s"((const char*)(gbase)), "s"(ldsb + (unsigned)((bufoff) + _i * 8192)) : "memory"); } } while (0)
#define PG8_LDA(dst, b, h) do { _Pragma("unroll") for (int m = 0; m < 4; ++m) _Pragma("unroll") for (int k = 0; k < 2; ++k) dst[m][k] = *(const PG8_LAS bf16x8*)(lds + PG8_SA(b, h) + aoff + m * 2048 + k * 1024); } while (0)
#define PG8_LDB(dst, b, h) do { _Pragma("unroll") for (int n = 0; n < 2; ++n) _Pragma("unroll") for (int k = 0; k < 2; ++k) dst[n][k] = *(const PG8_LAS bf16x8*)(lds + PG8_SB(b, h) + boff + n * 2048 + k * 1024); } while (0)
#define PG8_MMA(ai, bj, At, Bt) do { __builtin_amdgcn_s_setprio(1); _Pragma("unroll") for (int m = 0; m < 4; ++m) _Pragma("unroll") for (int n = 0; n < 2; ++n) _Pragma("unroll") for (int k = 0; k < 2; ++k) \
        acc[ai][bj][m][n] = __builtin_amdgcn_mfma_f32_16x16x32_bf16(Bt[n][k], At[m][k], acc[ai][bj][m][n], 0, 0, 0); __builtin_amdgcn_s_setprio(0); } while (0)
#define PG8_WAIT_V(n) asm volatile("s_waitcnt vmcnt(" #n ")" ::: "memory")
#define PG8_WAIT_L(n) asm volatile("s_waitcnt lgkmcnt(" #n ")" ::: "memory")
#define PG8_BAR __builtin_amdgcn_s_barrier()
#define PG8_SCHED __builtin_amdgcn_sched_barrier(0)
    Unit cur, nxt; int ui = 0;
    if (!S.next(0, cur)) return;
    f32x4 acc[2][2][4][2];
#pragma unroll
    for (int a = 0; a < 2; ++a)
#pragma unroll
        for (int b = 0; b < 2; ++b)
#pragma unroll
            for (int m = 0; m < 4; ++m)
#pragma unroll
                for (int n = 0; n < 2; ++n) acc[a][b][m][n] = (f32x4){0.f, 0.f, 0.f, 0.f};
    bf16x8 At[4][2], B0[2][2], B1[2][2];
    const char* cA = (const char*)g.A + (size_t)cur.pm * tstepA; const char* cB = (const char*)g.Bt + (size_t)cur.pn * tstepB;
    PG8_STAGE(PG8_SB(0, 0), cB, voffB); PG8_STAGE(PG8_SB(0, 1), cB + hstepB, voffB); PG8_STAGE(PG8_SA(0, 0), cA, voffA); PG8_STAGE(PG8_SA(0, 1), cA + hstepA, voffA);
    if (wr == 1) PG8_BAR;
    PG8_WAIT_V(2); PG8_BAR;
    PG8_STAGE(PG8_SB(1, 0), cB + kstep, voffB); PG8_STAGE(PG8_SA(1, 0), cA + kstep, voffA); PG8_STAGE(PG8_SB(1, 1), cB + hstepB + kstep, voffB);
    PG8_WAIT_V(6); PG8_BAR;
    for (;;) {
        const bool has_next = S.next(ui + 1, nxt);
        const char* nA = has_next ? (const char*)g.A + (size_t)nxt.pm * tstepA : cA; const char* nB = has_next ? (const char*)g.Bt + (size_t)nxt.pn * tstepB : cB;
#pragma unroll 1
        for (int t = 0; t < nt; t += 2) {
            if constexpr (EpiT::MIDK) { if (t != 0 && (t & 7) == 0) E.midk(acc, cur, t >> 3, wr, wc, fr, fq); }
            const bool last = (t == nt - 2);
            const char* a1 = cA + (size_t)(t + 1) * kstep;
            const char* a2 = last ? nA : cA + (size_t)(t + 2) * kstep; const char* b2 = last ? nB : cB + (size_t)(t + 2) * kstep;
            const char* a3 = a2 + kstep; const char* b3 = b2 + kstep;
            PG8_LDB(B0, 0, 0); PG8_LDB(B1, 0, 1); PG8_SCHED; PG8_LDA(At, 0, 0); PG8_STAGE(PG8_SA(1, 1), a1 + hstepA, voffA);
            PG8_WAIT_V(8); PG8_WAIT_L(0); PG8_BAR; PG8_MMA(0, 0, At, B0); PG8_MMA(0, 1, At, B1); PG8_BAR; PG8_SCHED;
            PG8_LDA(At, 0, 1); PG8_STAGE(PG8_SB(0, 0), b2, voffB); PG8_STAGE(PG8_SB(0, 1), b2 + hstepB, voffB); PG8_STAGE(PG8_SA(0, 0), a2, voffA);
            PG8_WAIT_V(8); PG8_WAIT_L(0); PG8_BAR; PG8_MMA(1, 0, At, B0); PG8_MMA(1, 1, At, B1); PG8_BAR; PG8_SCHED;
            PG8_LDB(B0, 1, 0); PG8_LDB(B1, 1, 1); PG8_SCHED; PG8_LDA(At, 1, 0); PG8_STAGE(PG8_SA(0, 1), a2 + hstepA, voffA);
            PG8_WAIT_V(8); PG8_WAIT_L(0); PG8_BAR; PG8_MMA(0, 0, At, B0); PG8_MMA(0, 1, At, B1); PG8_BAR; PG8_SCHED;
            PG8_LDA(At, 1, 1); PG8_STAGE(PG8_SB(1, 0), b3, voffB); PG8_STAGE(PG8_SB(1, 1), b3 + hstepB, voffB); PG8_STAGE(PG8_SA(1, 0), a3, voffA);
            PG8_WAIT_V(8); PG8_WAIT_L(0); PG8_BAR; PG8_MMA(1, 0, At, B0); PG8_MMA(1, 1, At, B1); PG8_BAR; PG8_SCHED;
        }
        if constexpr (ALIGN_EPI) { if (wr == 0) PG8_BAR; }
        asm volatile("s_nop 15\n\ts_nop 7" ::: "memory");
        E(acc, cur, wr, wc, fr, fq);
        if (!has_next) break;
#pragma unroll
        for (int a = 0; a < 2; ++a)
#pragma unroll
            for (int b = 0; b < 2; ++b)
#pragma unroll
                for (int m = 0; m < 4; ++m)
#pragma unroll
                    for (int n = 0; n < 2; ++n) acc[a][b][m][n] = (f32x4){0.f, 0.f, 0.f, 0.f};
        cur = nxt; cA = nA; cB = nB; ++ui;
        if constexpr (ALIGN_EPI) { if (wr == 1) PG8_BAR; }
    }
    PG8_WAIT_V(0);
    if constexpr (!ALIGN_EPI) { if (wr == 0) PG8_BAR; }
    PG8_BAR;
#undef PG8_SA
#undef PG8_SB
#undef PG8_STAGE
#undef PG8_LDA
#undef PG8_LDB
#undef PG8_MMA
#undef PG8_WAIT_V
#undef PG8_WAIT_L
#undef PG8_BAR
#undef PG8_SCHED
}
}

namespace att {
typedef short bf16x8 __attribute__((ext_vector_type(8)));
typedef short s16x4 __attribute__((ext_vector_type(4)));
typedef float f32x16 __attribute__((ext_vector_type(16)));
typedef unsigned u32x4 __attribute__((ext_vector_type(4)));
#define SBAR() __builtin_amdgcn_sched_barrier(0)
__device__ __forceinline__ int crow(int r, int hi) { return (r & 3) + 8 * (r >> 2) + 4 * hi; }
__device__ __forceinline__ unsigned cvtpk(float lo, float hi) { unsigned r; asm volatile("v_cvt_pk_bf16_f32 %0, %1, %2" : "=v"(r) : "v"(lo), "v"(hi)); return r; }
template <int KP> __device__ __forceinline__ int kswz(int row, int colB) {
    if (KP == 256) return row * 256 + (colB ^ ((row & 15) << 4));
    else return row * 128 + (colB ^ (((row >> 1) & 7) << 4));
}
constexpr float THR = 8.f;
#define max3f(a_, b_, c_) __builtin_fmaxf(__builtin_fmaxf((a_), (b_)), (c_))
__device__ __forceinline__ void partialSM(f32x16& p0, f32x16& p1, float& mhat, f32x16& negm, float& alpha, bool first) {
    float a = max3f(p0[0], p0[1], p1[0]), b = max3f(p0[2], p0[3], p1[1]); a = max3f(a, p1[2], p1[3]);
#pragma unroll
    for (int r = 4; r < 16; r += 4) { a = max3f(a, p0[r], p0[r + 1]); b = max3f(b, p0[r + 2], p0[r + 3]); a = max3f(a, p1[r], p1[r + 1]); b = max3f(b, p1[r + 2], p1[r + 3]); }
    float rm = max3f(a, b, b);
    { auto rr = __builtin_amdgcn_permlane32_swap(__float_as_uint(rm), __float_as_uint(rm), false, false);
      const float r0 = __uint_as_float(rr[0]), r1 = __uint_as_float(rr[1]); rm = max3f(r0, r1, r1); }
    alpha = 1.f;
    if (__builtin_expect(first || __any(rm > THR), 0)) {
        const float dl = first ? rm : fmaxf(rm, 0.f);
        mhat += dl;
#pragma unroll
        for (int r = 0; r < 16; ++r) { p0[r] -= dl; p1[r] -= dl; }
#pragma unroll
        for (int r = 0; r < 16; ++r) negm[r] = -mhat;
        alpha = __builtin_amdgcn_exp2f(-dl);
    }
#pragma unroll
    for (int r = 0; r < 16; ++r) p0[r] = __builtin_amdgcn_exp2f(p0[r]);
}
__device__ __forceinline__ void finishSM(f32x16& p0, f32x16& p1, bf16x8& pa0, bf16x8& pa1, bf16x8& pa2, bf16x8& pa3) {
#pragma unroll
    for (int r = 0; r < 16; ++r) p1[r] = __builtin_amdgcn_exp2f(p1[r]);
#define PK4(P, BASE, OUT) do { unsigned a0 = cvtpk(P[BASE + 0], P[BASE + 1]), a1 = cvtpk(P[BASE + 2], P[BASE + 3]);   \
    unsigned b0 = cvtpk(P[BASE + 4], P[BASE + 5]), b1 = cvtpk(P[BASE + 6], P[BASE + 7]);                              \
    u32x4 w = {a0, a1, b0, b1}; OUT = *reinterpret_cast<bf16x8*>(&w); } while (0)
    PK4(p0, 0, pa0); PK4(p0, 8, pa1); PK4(p1, 0, pa2); PK4(p1, 8, pa3);
#undef PK4
}
template <class C> __device__ __forceinline__ void qkt(f32x16& p0, f32x16& p1, const char* Ks, const bf16x8* qr, const f32x16& negm, int r32, int hi) {
#pragma unroll
    for (int d0 = 0; d0 < C::DK / 16; ++d0) { const int cb = (d0 * 16 + hi * 8) * 2;
        const bf16x8 b0 = *reinterpret_cast<const bf16x8*>(Ks + kswz<C::KP>(r32, cb));
        const bf16x8 b1 = *reinterpret_cast<const bf16x8*>(Ks + kswz<C::KP>(32 + r32, cb));
        if (d0 == 0) { p0 = __builtin_amdgcn_mfma_f32_32x32x16_bf16(b0, qr[0], negm, 0, 0, 0); p1 = __builtin_amdgcn_mfma_f32_32x32x16_bf16(b1, qr[0], negm, 0, 0, 0); }
        else { p0 = __builtin_amdgcn_mfma_f32_32x32x16_bf16(b0, qr[d0], p0, 0, 0, 0); p1 = __builtin_amdgcn_mfma_f32_32x32x16_bf16(b1, qr[d0], p1, 0, 0, 0); } }
}
template <int NCG> __device__ __forceinline__ int v_st(int k, int c) { const int kk = (k & ~0xC) | ((k & 4) << 1) | ((k & 8) >> 1); return ((kk >> 3) * NCG + (c >> 5)) * 512 + ((kk & 7) * 32 + (c & 31)) * 2; }
__device__ __forceinline__ int v_rd_base(int lane) { return ((lane & 3) << 3) | (((lane >> 2) & 3) << 6) | (((lane >> 4) & 1) << 5) | (((lane >> 5) & 1) << 8); }
template <int NCG> constexpr int v_rd_off(int d0, int ks, int half) { return ((2 * ks + half) * NCG + d0) * 512; }
typedef __attribute__((address_space(3))) const char* lds_cptr;
typedef short v4i16_t __attribute__((ext_vector_type(4)));
__device__ __forceinline__ s16x4 vtr(lds_cptr p) { return __builtin_bit_cast(s16x4, __builtin_amdgcn_ds_read_tr16_b64_v4i16((__attribute__((address_space(3))) v4i16_t*)p)); }
template <int NCG, int D0> __device__ __forceinline__ void pv_one(f32x16& od, lds_cptr vp, bf16x8 pa0, bf16x8 pa1, bf16x8 pa2, bf16x8 pa3) {
    const s16x4 l0 = vtr(vp + v_rd_off<NCG>(D0, 0, 0)), h0 = vtr(vp + v_rd_off<NCG>(D0, 0, 1)), l1 = vtr(vp + v_rd_off<NCG>(D0, 1, 0)), h1 = vtr(vp + v_rd_off<NCG>(D0, 1, 1));
    const s16x4 l2 = vtr(vp + v_rd_off<NCG>(D0, 2, 0)), h2 = vtr(vp + v_rd_off<NCG>(D0, 2, 1)), l3 = vtr(vp + v_rd_off<NCG>(D0, 3, 0)), h3 = vtr(vp + v_rd_off<NCG>(D0, 3, 1));
#define PK(L, H) (bf16x8){L[0], L[1], L[2], L[3], H[0], H[1], H[2], H[3]}
    od = __builtin_amdgcn_mfma_f32_32x32x16_bf16(pa0, PK(l0, h0), od, 0, 0, 0);
    od = __builtin_amdgcn_mfma_f32_32x32x16_bf16(pa1, PK(l1, h1), od, 0, 0, 0);
    od = __builtin_amdgcn_mfma_f32_32x32x16_bf16(pa2, PK(l2, h2), od, 0, 0, 0);
    od = __builtin_amdgcn_mfma_f32_32x32x16_bf16(pa3, PK(l3, h3), od, 0, 0, 0);
#undef PK
}

struct Args {
    const bf16* Q; int ldq;
    const bf16* K1A; const bf16* K1B; int ldk1A, ldk1B;
    const bf16* K2A; const bf16* K2B;
    const bf16* VA; const bf16* VB; int ldvA, ldvB;
    int nA, NT;
    void* O; int ldo;
    const float* rope; int t0;
    const float* rpb; int r0; int kr_lo;
    int comb; float lam, post; const float* ng; bf16* Of; int ldof;
};
__device__ __forceinline__ void glds16(const void* gsrc, unsigned lds_dst) { unsigned keep;
    asm volatile("s_mov_b32 %0, m0\n\ts_mov_b32 m0, %2\n\ts_nop 0\n\tglobal_load_lds_dwordx4 %1, off\n\ts_mov_b32 m0, %0" : "=&s"(keep) : "v"(gsrc), "s"(lds_dst) : "memory"); }
template <class C> __device__ __forceinline__ void attn_unit(const Args& a, char* lds) {
    constexpr int DK = C::DK, DK1 = C::DK1, DV = C::DV, KP = C::KP, NCG = DV / 32;
    constexpr int SHM_V = 64 * DV * 2, SHM_K = 64 * KP, SLOT = SHM_V + SHM_K, RING = 4;
    constexpr int KCH = SHM_K / 8192, VCH = SHM_V / 8192, NDMA = KCH + VCH;
    int tid = threadIdx.x; asm volatile("" : "+v"(tid));
    const int wid = __builtin_amdgcn_readfirstlane(tid >> 6), lane = tid & 63, r32 = lane & 31, hi = lane >> 5;
    float* wsf = (float*)(lds + RING * SLOT) + wid * 64; float* al_l = wsf + 32;
    float* rpb_l = (float*)(lds + RING * SLOT + NWAVES * 256);
    constexpr float Cs = C::SCALE * 1.4426950408889634f;
    float mhat = 0.f; f32x16 negm = f32x16{}; bool first = true; f32x16 o[NCG]; f32x16 ol = f32x16{}; bf16x8 qr[DK / 16];
#pragma unroll
    for (int d = 0; d < NCG; ++d) o[d] = f32x16{};
    __syncthreads();
    if constexpr (C::NAWIN) { for (int i = tid; i < 15 * 32; i += 512) { const int dr = i >> 5, dc = i & 31; rpb_l[i] = (dc < 31) ? a.rpb[dr * 31 + dc] * 1.4426950408889634f : 0.f; } }
    int krow[KCH], kcol[KCH]; bool kval[KCH]; int vrow[VCH], vcol[VCH];
#pragma unroll
    for (int k = 0; k < KCH; ++k) { const int off = ((k * 8 + wid) * 64 + lane) * 16; const int row = off / KP, cbp = off % KP;
        const int swz = (KP == 256) ? ((row & 15) << 4) : (((row >> 1) & 7) << 4); const int col = (cbp ^ swz) >> 1;
        krow[k] = row; kval[k] = col < DK; kcol[k] = kval[k] ? col : 0; }
#pragma unroll
    for (int k = 0; k < VCH; ++k) { const int off = ((k * 8 + wid) * 64 + lane) * 16; const int sub = off >> 9, kkh = sub / NCG, cg = sub % NCG, within = (off & 511) >> 1;
        const int kk = kkh * 8 + (within >> 5); const int key = kk;
        vrow[k] = key; vcol[k] = cg * 32 + (within & 31); }
    const unsigned lds0 = (unsigned)(uintptr_t)lds;
#define ATT_DMA(j_) do { const int jt_ = (j_); const bool sb_ = jt_ >= a.nA; const int jj_ = sb_ ? jt_ - a.nA : jt_;                                    \
        const bf16* k1_ = (sb_ ? a.K1B : a.K1A) + (size_t)jj_ * 64 * (sb_ ? a.ldk1B : a.ldk1A); const int l1_ = sb_ ? a.ldk1B : a.ldk1A;                  \
        const bf16* k2_ = (sb_ ? a.K2B : a.K2A) + (size_t)jj_ * 64 * 32;                                                                                  \
        const bf16* v_ = (sb_ ? a.VB : a.VA) + (size_t)jj_ * 64 * (sb_ ? a.ldvB : a.ldvA); const int lv_ = sb_ ? a.ldvB : a.ldvA;                         \
        const unsigned sl_ = lds0 + (unsigned)((jt_ & (RING - 1)) * SLOT);                                                                                 \
        _Pragma("unroll") for (int k_ = 0; k_ < VCH; ++k_)                                                                                                \
            glds16(v_ + vrow[k_] * lv_ + vcol[k_], (unsigned)__builtin_amdgcn_readfirstlane(sl_ + (k_ * 8 + wid) * 1024));                                 \
        _Pragma("unroll") for (int k_ = 0; k_ < KCH; ++k_) { {                                                                                            \
            const bf16* src_ = (DK1 == DK || kcol[k_] < DK1) ? k1_ + krow[k_] * l1_ + kcol[k_] : k2_ + krow[k_] * 32 + (kcol[k_] - DK1);                   \
            glds16(src_, (unsigned)__builtin_amdgcn_readfirstlane(sl_ + SHM_V + (k_ * 8 + wid) * 1024)); } } } while (0)
    const int NT = a.NT;
    ATT_DMA(0); if (1 < NT) ATT_DMA(1);
    const bf16* Qw = a.Q + (size_t)(wid * 32 + r32) * a.ldq + hi * 8;
#pragma unroll
    for (int d0 = 0; d0 < DK / 16; ++d0) qr[d0] = *reinterpret_cast<const bf16x8*>(Qw + d0 * 16);
    if constexpr (C::QROPE) {
        if (a.rope) {
            const float* rp = a.rope + (size_t)(a.t0 + wid * 32 + r32) * 32 + hi * 8;
            bf16x8 x1 = qr[4], x2 = qr[5], y1, y2;
            const f32x4 c0 = *(const f32x4*)rp, c1 = *(const f32x4*)(rp + 4), s0 = *(const f32x4*)(rp + 16), s1 = *(const f32x4*)(rp + 20);
            const float csv[8] = {c0.x, c0.y, c0.z, c0.w, c1.x, c1.y, c1.z, c1.w}, snv[8] = {s0.x, s0.y, s0.z, s0.w, s1.x, s1.y, s1.z, s1.w};
#pragma unroll
            for (int e = 0; e < 8; ++e) { const float cs = csv[e], sn = snv[e]; const float u1 = bf1((bf16)x1[e]), u2 = bf1((bf16)x2[e]);
                y1[e] = (short)f2bf(u1 * cs - u2 * sn); y2[e] = (short)f2bf(u2 * cs + u1 * sn); }
            qr[4] = y1; qr[5] = y2;
        }
    }
#pragma unroll
    for (int d0 = 0; d0 < DK / 16; ++d0) { bf16x8 x = qr[d0], y;
#pragma unroll
        for (int e = 0; e < 8; ++e) y[e] = (short)f2bf(bf1((bf16)x[e]) * Cs);
        qr[d0] = y; }
    asm volatile("s_waitcnt vmcnt(0)" ::: "memory");
    const lds_cptr vp0 = (lds_cptr)lds + v_rd_base(lane);
    int rq = 0, st_w = 0, qc = 0, cs_w = 0;
    if constexpr (C::NAWIN) { rq = a.r0 + (wid >> 1); st_w = min(max(rq - 4, 0), 56); qc = (wid & 1) * 32 + r32; cs_w = min(max(qc - 8, 0), 48); }
#define ATT_ACTIVE(i_) (!C::NAWIN || (i_) >= a.nA || ((a.kr_lo + (i_)) >= st_w && (a.kr_lo + (i_)) < st_w + 8))
    if (wid >= 4) __builtin_amdgcn_s_setprio(1);
    if constexpr (C::NAWIN) {
    f32x16 pp0 = f32x16{}, pp1 = f32x16{}; bool act_p = false;
#pragma unroll 2
    for (int i = 0; i <= NT; ++i) {
        if (i + 1 < NT) asm volatile("s_waitcnt vmcnt(%0) lgkmcnt(0)\n\ts_barrier" :: "n"(NDMA) : "memory");
        else asm volatile("s_waitcnt vmcnt(0) lgkmcnt(0)\n\ts_barrier" ::: "memory");
        if (i + 2 < NT) ATT_DMA(i + 2);
        const bool act = (i < NT) && ATT_ACTIVE(i);
        f32x16 pc0 = f32x16{}, pc1 = f32x16{}; float alpha = 1.f; bf16x8 pa0, pa1, pa2, pa3;
        SBAR();
        if (act) qkt<C>(pc0, pc1, lds + (i & (RING - 1)) * SLOT + SHM_V, qr, negm, r32, hi);
        if (act_p) finishSM(pp0, pp1, pa0, pa1, pa2, pa3);
        SBAR();
        if (act_p) { const lds_cptr vp = vp0 + ((i - 1) & (RING - 1)) * SLOT;
            pv_one<NCG, 0>(o[0], vp, pa0, pa1, pa2, pa3); pv_one<NCG, 1>(o[1], vp, pa0, pa1, pa2, pa3);
            if constexpr (NCG == 4) { pv_one<NCG, 2>(o[2], vp, pa0, pa1, pa2, pa3); pv_one<NCG, 3>(o[3], vp, pa0, pa1, pa2, pa3); }
            { const bf16x8 ones = {(short)0x3F80, (short)0x3F80, (short)0x3F80, (short)0x3F80, (short)0x3F80, (short)0x3F80, (short)0x3F80, (short)0x3F80};
              ol = __builtin_amdgcn_mfma_f32_32x32x16_bf16(pa0, ones, ol, 0, 0, 0); ol = __builtin_amdgcn_mfma_f32_32x32x16_bf16(pa1, ones, ol, 0, 0, 0);
              ol = __builtin_amdgcn_mfma_f32_32x32x16_bf16(pa2, ones, ol, 0, 0, 0); ol = __builtin_amdgcn_mfma_f32_32x32x16_bf16(pa3, ones, ol, 0, 0, 0); } }
        if (act) {
            if constexpr (C::NAWIN) {
                if (i < a.nA) {
                    const int kr = a.kr_lo + i; const int dr = kr - rq + 7;
#pragma unroll
                    for (int r = 0; r < 16; ++r) { const int kc0 = crow(r, hi), kc1 = kc0 + 32;
                        const bool v0 = (kc0 >= cs_w) && (kc0 < cs_w + 16), v1 = (kc1 >= cs_w) && (kc1 < cs_w + 16);
                        const float b0 = rpb_l[v0 ? dr * 32 + (kc0 - qc + 15) : 0], b1 = rpb_l[v1 ? dr * 32 + (kc1 - qc + 15) : 0];
                        pc0[r] = v0 ? pc0[r] + b0 : -1e30f; pc1[r] = v1 ? pc1[r] + b1 : -1e30f; }
                }
            }
            partialSM(pc0, pc1, mhat, negm, alpha, first);
            if (!first && __any(alpha != 1.f)) { if (hi == 0) al_l[r32] = alpha; asm volatile("s_waitcnt lgkmcnt(0)" ::: "memory");
#pragma unroll
                for (int r = 0; r < 16; ++r) { const float al = al_l[crow(r, hi)]; ol[r] *= al;
#pragma unroll
                    for (int d = 0; d < NCG; ++d) o[d][r] *= al; } }
            first = false;
        }
        pp0 = pc0; pp1 = pc1; act_p = act;
    }
    } else {
        constexpr int ND = DK / 16, EXPF = (ND == 6) ? 16 : 8, NPX = 32 - EXPF, PXR = NPX / NCG, KPF = (NCG == 4) ? 1 : 2;
        static_assert(NPX % NCG == 0, "exp split");
#define ATT_MF(a_, b_, c_) __builtin_amdgcn_mfma_f32_32x32x16_bf16((a_), (b_), (c_), 0, 0, 0)
#define ATT_KLD(Ks_, d0_, h_) (*reinterpret_cast<const bf16x8*>((Ks_) + kswz<KP>((h_) * 32 + r32, ((d0_) * 16 + hi * 8) * 2)))
#define ATT_VRD(dst_, vp_, D0_) do { _Pragma("unroll") for (int ks_ = 0; ks_ < 4; ++ks_) { dst_[2 * ks_] = vtr((vp_) + v_rd_off<NCG>(D0_, ks_, 0)); dst_[2 * ks_ + 1] = vtr((vp_) + v_rd_off<NCG>(D0_, ks_, 1)); } } while (0)
#define ATT_PKV(L, H) (bf16x8){L[0], L[1], L[2], L[3], H[0], H[1], H[2], H[3]}
#define ATT_VMM(od_, v_) do { od_ = ATT_MF(pa0, ATT_PKV(v_[0], v_[1]), od_); od_ = ATT_MF(pa1, ATT_PKV(v_[2], v_[3]), od_); od_ = ATT_MF(pa2, ATT_PKV(v_[4], v_[5]), od_); od_ = ATT_MF(pa3, ATT_PKV(v_[6], v_[7]), od_); } while (0)
#define ATT_ONES() do { const bf16x8 ones = {(short)0x3F80, (short)0x3F80, (short)0x3F80, (short)0x3F80, (short)0x3F80, (short)0x3F80, (short)0x3F80, (short)0x3F80};     \
            ol = ATT_MF(pa0, ones, ol); ol = ATT_MF(pa1, ones, ol); ol = ATT_MF(pa2, ones, ol); ol = ATT_MF(pa3, ones, ol); } while (0)
#define ATT_PK4(P, BASE, OUT) do { unsigned a0 = cvtpk(P[BASE + 0], P[BASE + 1]), a1 = cvtpk(P[BASE + 2], P[BASE + 3]);   \
            unsigned b0 = cvtpk(P[BASE + 4], P[BASE + 5]), b1 = cvtpk(P[BASE + 6], P[BASE + 7]);                              \
            u32x4 w = {a0, a1, b0, b1}; OUT = *reinterpret_cast<bf16x8*>(&w); } while (0)
#define ATT_PX(p0_, p1_, x_) do { float t_ = __builtin_amdgcn_exp2f(((x_) < 16) ? p0_[(x_) & 15] : p1_[((x_) - 16) & 15]); asm volatile("" : "+v"(t_));     \
            if ((x_) < 16) p0_[(x_) & 15] = t_; else p1_[((x_) - 16) & 15] = t_; } while (0)
        f32x16 pp0, pp1; float alpha = 1.f;
        if (1 < NT) asm volatile("s_waitcnt vmcnt(%0) lgkmcnt(0)\n\ts_barrier" :: "n"(NDMA) : "memory");
        else asm volatile("s_waitcnt vmcnt(0) lgkmcnt(0)\n\ts_barrier" ::: "memory");
        if (2 < NT) ATT_DMA(2);
        SBAR();
        qkt<C>(pp0, pp1, lds + SHM_V, qr, negm, r32, hi);
        partialSM(pp0, pp1, mhat, negm, alpha, true);
#pragma unroll
        for (int x = 16; x < NPX; ++x) ATT_PX(pp0, pp1, x);
        SBAR();
        const bf16* pvp[VCH]; const bf16* pkp[KCH]; size_t svb = 0, skb[KCH];
#define ATT_PTR_INIT(j_) do { const int jq_ = (j_); const bool sb_ = jq_ >= a.nA; const int jj_ = sb_ ? jq_ - a.nA : jq_;                                          \
            const bf16* k1_ = (sb_ ? a.K1B : a.K1A) + (size_t)jj_ * 64 * (sb_ ? a.ldk1B : a.ldk1A); const int l1_ = sb_ ? a.ldk1B : a.ldk1A;                       \
            const bf16* k2_ = (sb_ ? a.K2B : a.K2A) + (size_t)jj_ * 64 * 32;                                                                                       \
            const bf16* v_ = (sb_ ? a.VB : a.VA) + (size_t)jj_ * 64 * (sb_ ? a.ldvB : a.ldvA); const int lv_ = sb_ ? a.ldvB : a.ldvA;                              \
            _Pragma("unroll") for (int k_ = 0; k_ < VCH; ++k_) pvp[k_] = v_ + vrow[k_] * lv_ + vcol[k_];                                                           \
            svb = (size_t)64 * lv_;                                                                                                                                \
            _Pragma("unroll") for (int k_ = 0; k_ < KCH; ++k_) { const bool n1_ = (DK1 == DK || kcol[k_] < DK1);                                                   \
                pkp[k_] = n1_ ? k1_ + krow[k_] * l1_ + kcol[k_] : k2_ + krow[k_] * 32 + (kcol[k_] - DK1); skb[k_] = n1_ ? (size_t)64 * l1_ : (size_t)64 * 32; } } while (0)
        ATT_PTR_INIT(3);
#pragma unroll 2
        for (int i = 1; i < NT; ++i) {
            if (i + 1 < NT) asm volatile("s_waitcnt vmcnt(%0) lgkmcnt(0)\n\ts_barrier" :: "n"(NDMA) : "memory");
            else asm volatile("s_waitcnt vmcnt(0) lgkmcnt(0)\n\ts_barrier" ::: "memory");
            const bool dma_on = i + 2 < NT;
            const int jt_ = i + 2;
            if (jt_ == a.nA) ATT_PTR_INIT(jt_);
            const unsigned sl_ = lds0 + (unsigned)((jt_ & (RING - 1)) * SLOT);
#define ATT_PIECE_V(k_) do { if (dma_on) glds16(pvp[k_], (unsigned)__builtin_amdgcn_readfirstlane(sl_ + ((k_) * 8 + wid) * 1024)); pvp[k_] += svb; } while (0)
#define ATT_PIECE_K(k_) do { if (dma_on) glds16(pkp[k_], (unsigned)__builtin_amdgcn_readfirstlane(sl_ + SHM_V + ((k_) * 8 + wid) * 1024)); pkp[k_] += skb[k_]; } while (0)
            static_assert((VCH == 1 && KCH <= 2) || (VCH == 2 && KCH == 1), "piece placement");
            f32x16 pc0, pc1; bf16x8 pa0, pa1, pa2, pa3; bf16x8 ka[ND], kb[ND]; s16x4 va[8], vb[8];
            const char* Ks = lds + (i & (RING - 1)) * SLOT + SHM_V; const lds_cptr vp = vp0 + ((i - 1) & (RING - 1)) * SLOT;
            SBAR();
#pragma unroll
            for (int d0 = 0; d0 < KPF; ++d0) { ka[d0] = ATT_KLD(Ks, d0, 0); kb[d0] = ATT_KLD(Ks, d0, 1); }
            SBAR();
#pragma unroll
            for (int d0 = 0; d0 < ND; ++d0) {
                if (d0 + KPF < ND) { ka[d0 + KPF] = ATT_KLD(Ks, d0 + KPF, 0); kb[d0 + KPF] = ATT_KLD(Ks, d0 + KPF, 1); }
                if constexpr (NCG == 2) { if (d0 == ND - 1) ATT_VRD(va, vp, 0); }
                if (d0 == 0) { pc0 = ATT_MF(ka[0], qr[0], negm); pc1 = ATT_MF(kb[0], qr[0], negm); }
                else { pc0 = ATT_MF(ka[d0], qr[d0], pc0); pc1 = ATT_MF(kb[d0], qr[d0], pc1); }
#pragma unroll
                for (int e = (16 - EXPF) + (d0 * EXPF) / ND; e < (16 - EXPF) + ((d0 + 1) * EXPF) / ND; ++e) pp1[e] = __builtin_amdgcn_exp2f(pp1[e]);
                if (d0 == 0) ATT_PIECE_V(0);
                if constexpr (VCH == 2) { if (d0 == 1) ATT_PIECE_V(1); if (d0 == 2) ATT_PIECE_K(0); }
                else { if (d0 == 1) ATT_PIECE_K(0); if constexpr (KCH == 2) { if (d0 == 3) ATT_PIECE_K(1); } }
                if (d0 == 0) ATT_PK4(pp0, 0, pa0);
                if (d0 == 1) ATT_PK4(pp0, 8, pa1);
                if (d0 == ND / 2) ATT_PK4(pp1, 0, pa2);
                if (d0 == ND - 1) ATT_PK4(pp1, 8, pa3);
                SBAR();
            }
            if constexpr (NCG == 4) ATT_VRD(va, vp, 0);
            ATT_VRD(vb, vp, 1);
            ATT_VMM(o[0], va);
            float rm;
            { float a = max3f(pc0[0], pc0[1], pc1[0]), b = max3f(pc0[2], pc0[3], pc1[1]); a = max3f(a, pc1[2], pc1[3]);
#pragma unroll
              for (int r = 4; r < 16; r += 4) { a = max3f(a, pc0[r], pc0[r + 1]); b = max3f(b, pc0[r + 2], pc0[r + 3]); a = max3f(a, pc1[r], pc1[r + 1]); b = max3f(b, pc1[r + 2], pc1[r + 3]); }
              rm = max3f(a, b, b);
              auto rr = __builtin_amdgcn_permlane32_swap(__float_as_uint(rm), __float_as_uint(rm), false, false);
              const float r0 = __uint_as_float(rr[0]), r1 = __uint_as_float(rr[1]); rm = max3f(r0, r1, r1); }
            SBAR();
            alpha = 1.f;
            if (__builtin_expect(__any(rm > THR), 0)) {
                const float dl = fmaxf(rm, 0.f);
                mhat += dl;
#pragma unroll
                for (int r = 0; r < 16; ++r) { pc0[r] -= dl; pc1[r] -= dl; }
#pragma unroll
                for (int r = 0; r < 16; ++r) negm[r] = -mhat;
                alpha = __builtin_amdgcn_exp2f(-dl);
            }
            SBAR();
            if constexpr (NCG == 2) {
                ATT_VMM(o[1], vb);
#pragma unroll
                for (int x = 0; x < PXR; ++x) ATT_PX(pc0, pc1, x);
                SBAR();
                ATT_ONES();
#pragma unroll
                for (int x = PXR; x < 2 * PXR; ++x) ATT_PX(pc0, pc1, x);
                SBAR();
            } else {
                ATT_VRD(va, vp, 2);
                ATT_VMM(o[1], vb);
#pragma unroll
                for (int x = 0; x < PXR; ++x) ATT_PX(pc0, pc1, x);
                SBAR();
                ATT_VRD(vb, vp, 3);
                ATT_VMM(o[2], va);
#pragma unroll
                for (int x = PXR; x < 2 * PXR; ++x) ATT_PX(pc0, pc1, x);
                SBAR();
                ATT_VMM(o[3], vb);
#pragma unroll
                for (int x = 2 * PXR; x < 3 * PXR; ++x) ATT_PX(pc0, pc1, x);
                SBAR();
                ATT_ONES();
#pragma unroll
                for (int x = 3 * PXR; x < 4 * PXR; ++x) ATT_PX(pc0, pc1, x);
                SBAR();
            }
            if (__any(alpha != 1.f)) { if (hi == 0) al_l[r32] = alpha; asm volatile("s_waitcnt lgkmcnt(0)" ::: "memory");
#pragma unroll
                for (int r = 0; r < 16; ++r) { const float al = al_l[crow(r, hi)]; ol[r] *= al;
#pragma unroll
                    for (int d = 0; d < NCG; ++d) o[d][r] *= al; } }
            pp0 = pc0; pp1 = pc1;
        }
        { bf16x8 pa0, pa1, pa2, pa3; const lds_cptr vp = vp0 + ((NT - 1) & (RING - 1)) * SLOT;
          SBAR();
#pragma unroll
          for (int e = 16 - EXPF; e < 16; ++e) pp1[e] = __builtin_amdgcn_exp2f(pp1[e]);
          ATT_PK4(pp0, 0, pa0); ATT_PK4(pp0, 8, pa1); ATT_PK4(pp1, 0, pa2); ATT_PK4(pp1, 8, pa3);
          SBAR();
          pv_one<NCG, 0>(o[0], vp, pa0, pa1, pa2, pa3); pv_one<NCG, 1>(o[1], vp, pa0, pa1, pa2, pa3);
          if constexpr (NCG == 4) { pv_one<NCG, 2>(o[2], vp, pa0, pa1, pa2, pa3); pv_one<NCG, 3>(o[3], vp, pa0, pa1, pa2, pa3); }
          ATT_ONES(); }
#undef ATT_MF
#undef ATT_KLD
#undef ATT_VRD
#undef ATT_PKV
#undef ATT_VMM
#undef ATT_ONES
#undef ATT_PK4
#undef ATT_PX
#undef ATT_PIECE_V
#undef ATT_PIECE_K
#undef ATT_PTR_INIT
    }
    __builtin_amdgcn_s_setprio(0);
#undef ATT_ACTIVE
#undef ATT_DMA
    float rli[16];
#pragma unroll
    for (int r = 0; r < 16; ++r) rli[r] = __builtin_amdgcn_rcpf(ol[r]);
    if constexpr (C::OUT_F32) {
        float* Ow = (float*)a.O + (size_t)(wid * 32) * a.ldo;
        if (a.comb == 0) {
#pragma unroll
            for (int r = 0; r < 16; ++r) { const int orow = crow(r, hi);
#pragma unroll
                for (int d0 = 0; d0 < NCG; ++d0) Ow[(size_t)orow * a.ldo + d0 * 32 + r32] = o[d0][r] * rli[r]; }
        } else {
            asm volatile("s_waitcnt vmcnt(0)" ::: "memory");
            bf16* Of = a.Of + (size_t)(wid * 32) * a.ldof;
            float ngv[NCG]; unsigned w1[16][NCG];
#pragma unroll
            for (int d0 = 0; d0 < NCG; ++d0) ngv[d0] = a.ng[d0 * 32 + r32];
#pragma unroll
            for (int r = 0; r < 16; ++r)
#pragma unroll
                for (int d0 = 0; d0 < NCG; ++d0) w1[r][d0] = __hip_atomic_load((unsigned*)(Ow + (size_t)crow(r, hi) * a.ldo + d0 * 32 + r32), __ATOMIC_RELAXED, __HIP_MEMORY_SCOPE_AGENT);
            __builtin_amdgcn_sched_barrier(0);
#pragma unroll
            for (int r = 0; r < 16; ++r) { const int orow = crow(r, hi); float v[NCG]; float ss = 0.f;
#pragma unroll
                for (int d0 = 0; d0 < NCG; ++d0) { v[d0] = __uint_as_float(w1[r][d0]) - a.lam * (o[d0][r] * rli[r]); ss += v[d0] * v[d0]; }
                ss += __shfl_xor(ss, 1); ss += __shfl_xor(ss, 2); ss += __shfl_xor(ss, 4); ss += __shfl_xor(ss, 8); ss += __shfl_xor(ss, 16);
                const float rs = a.post / sqrtf(ss * (1.0f / (32 * NCG)) + 1e-6f);
#pragma unroll
                for (int d0 = 0; d0 < NCG; ++d0) Of[(size_t)orow * a.ldof + d0 * 32 + r32] = f2bf(v[d0] * rs * ngv[d0]); }
        }
    } else {
        bf16* Ow = (bf16*)a.O + (size_t)(wid * 32) * a.ldo;
#pragma unroll
        for (int r = 0; r < 16; ++r) { const int orow = crow(r, hi);
#pragma unroll
            for (int d0 = 0; d0 < NCG; ++d0) Ow[(size_t)orow * a.ldo + d0 * 32 + r32] = f2bf(o[d0][r] * rli[r]); }
    }
}
struct CfgMLA  { static constexpr int DK = 96, DK1 = 64, DV = 64,  KP = 256; static constexpr float SCALE = 0.10206207261596577f; static constexpr bool OUT_F32 = false, NAWIN = false, QROPE = true; };
struct CfgNA   { static constexpr int DK = 64, DK1 = 64, DV = 64,  KP = 128; static constexpr float SCALE = 0.125f; static constexpr bool OUT_F32 = false, NAWIN = false, QROPE = false; };
struct CfgNAW  { static constexpr int DK = 64, DK1 = 64, DV = 64,  KP = 128; static constexpr float SCALE = 0.125f; static constexpr bool OUT_F32 = false, NAWIN = true,  QROPE = false; };
struct CfgDIFF { static constexpr int DK = 64, DK1 = 64, DV = 128, KP = 128; static constexpr float SCALE = 0.125f; static constexpr bool OUT_F32 = true,  NAWIN = false, QROPE = false; };
#undef SBAR
}

#define XB_TMO      128
#define XB_XCNT(j)  (256  + 64 * (j))
#define XB_XSUB(j)  (1280 + 64 * (j))
#define XB_XGEN(j)  (2304 + 64 * (j))
#define XB_TOP      3328
#define XB_TOPGEN   3392
#define XCD_BAR_WORDS 3456
#define XB_SPIN_CAP (1u << 18)
__device__ __forceinline__ unsigned xb_ld(unsigned* p)              { return __hip_atomic_load(p, __ATOMIC_RELAXED, __HIP_MEMORY_SCOPE_AGENT); }
__device__ __forceinline__ unsigned xb_add(unsigned* p, unsigned v) { return __hip_atomic_fetch_add(p, v, __ATOMIC_RELAXED, __HIP_MEMORY_SCOPE_AGENT); }
__device__ __forceinline__ unsigned xb_xcc_id() { return (unsigned)__builtin_amdgcn_s_getreg((3 << 11) | 20) & 0xFu; }
#define XB_SPIN(cond, bar) do { unsigned _sp = 0; while (cond) { __builtin_amdgcn_s_sleep(1); \
    if ((++_sp & 255u) == 0u) { if (xb_ld(&(bar)[XB_TMO])) break; if (_sp > XB_SPIN_CAP) { atomicAdd(&(bar)[XB_TMO], 1u); break; } } } } while (0)
struct XcdBarrier { unsigned* bar; unsigned x; volatile LAS unsigned* st; };
__device__ __forceinline__ XcdBarrier xcd_barrier_post(unsigned* bar, volatile LAS unsigned* st) {
    XcdBarrier b; b.bar = bar; b.x = xb_xcc_id(); b.st = st;
    if (threadIdx.x == 0) (void)xb_add(&bar[XB_XCNT(b.x)], 1u);
    return b;
}
__device__ __forceinline__ void xcd_barrier_complete(unsigned* bar, unsigned x, unsigned& nloc, unsigned& nx) {
    const unsigned G = gridDim.x * gridDim.y * gridDim.z;
    unsigned sum, cnt, mine, sp = 0u;
    for (;;) {
        sum = 0u; cnt = 0u; mine = 0u;
#pragma unroll
        for (unsigned j = 0; j < 16; ++j) { const unsigned c = xb_ld(&bar[XB_XCNT(j)]); sum += c; cnt += (c > 0u) ? 1u : 0u; mine = (j == x) ? c : mine; }
        if (sum == G) break;
        __builtin_amdgcn_s_sleep(1);
        if ((++sp & 255u) == 0u) { if (xb_ld(&bar[XB_TMO])) break; if (sp > XB_SPIN_CAP) { atomicAdd(&bar[XB_TMO], 1u); break; } }
    }
    nloc = mine > 0u ? mine : 1u; nx = cnt > 0u ? cnt : 1u;
}
__device__ __forceinline__ void xcd_barrier(const XcdBarrier& b) {
    asm volatile("s_waitcnt vmcnt(0)" ::: "memory");
    __syncthreads();
    if (threadIdx.x == 0) {
        unsigned* bar = b.bar;
        __builtin_amdgcn_s_waitcnt(0);
        unsigned nloc = b.st[0], nx = b.st[1];
        if (nloc == 0u) { xcd_barrier_complete(bar, b.x, nloc, nx); b.st[0] = nloc; b.st[1] = nx; }
        const unsigned old = xb_add(&bar[XB_XSUB(b.x)], 1u);
        const unsigned gen = old / nloc;
        if (old + 1u == (gen + 1u) * nloc) {
            __builtin_amdgcn_fence(__ATOMIC_RELEASE, "agent");
            asm volatile("s_waitcnt vmcnt(0)" ::: "memory");
            const unsigned og = xb_add(&bar[XB_TOP], 1u);
            const unsigned tg = og / nx;
            if (og + 1u == (tg + 1u) * nx) xb_add(&bar[XB_TOPGEN], 1u);
            else XB_SPIN(xb_ld(&bar[XB_TOPGEN]) == tg, bar);
            __builtin_amdgcn_fence(__ATOMIC_ACQUIRE, "agent");
            xb_add(&bar[XB_XGEN(b.x)], 1u);
            asm volatile("s_waitcnt vmcnt(0)" ::: "memory");
        } else {
            XB_SPIN(xb_ld(&bar[XB_XGEN(b.x)]) == gen, bar);
            __builtin_amdgcn_fence(__ATOMIC_ACQUIRE, "agent");
            asm volatile("s_waitcnt vmcnt(0)" ::: "memory");
        }
    }
    __syncthreads();
}

__device__ __forceinline__ void transpose_item(const float* W, int Nsrc, int src_k0, int src_n0, bf16* WT, int Kdst, int dst_k0, int dst_n0, LAS float* scr, int lane) {
    f32x4 v[8];
    const int kk0 = lane >> 3, n4 = (lane & 7) * 4;
    if (src_n0 >= 0) {
#pragma unroll
        for (int i = 0; i < 8; ++i) v[i] = __builtin_nontemporal_load((const f32x4*)(W + (size_t)(src_k0 + kk0 + 8 * i) * Nsrc + src_n0 + n4));
    } else {
#pragma unroll
        for (int i = 0; i < 8; ++i) v[i] = (f32x4){0.f, 0.f, 0.f, 0.f};
    }
#pragma unroll
    for (int i = 0; i < 8; ++i) { LAS float* d = scr + (kk0 + 8 * i) * 33 + n4; d[0] = v[i].x; d[1] = v[i].y; d[2] = v[i].z; d[3] = v[i].w; }
    LDS_WAIT(); asm volatile("" ::: "memory");
    const int c = lane & 7;
#pragma unroll
    for (int j = 0; j < 4; ++j) { const int n = (lane >> 3) + 8 * j; const LAS float* s = scr + (8 * c) * 33 + n;
        v4u o; o.x = cvt_pk_bf16(s[0 * 33], s[1 * 33]); o.y = cvt_pk_bf16(s[2 * 33], s[3 * 33]); o.z = cvt_pk_bf16(s[4 * 33], s[5 * 33]); o.w = cvt_pk_bf16(s[6 * 33], s[7 * 33]);
        *(GAS v4u*)(WT + (size_t)(dst_n0 + n) * Kdst + dst_k0 + 8 * c) = o; }
    LDS_WAIT(); asm volatile("" ::: "memory");
}

struct KArgs { const float* in[27]; float* out; unsigned char* ws; int ph_lo, ph_hi; };
typedef const __attribute__((address_space(4))) KArgs* KAP;

__device__ __forceinline__ void wconv_layer(KAP P, int L, LAS float* scr, int gw, int NGW, int lane) {
    bf16* WT = (bf16*)(P->ws + WS_WT);
    const float* w_in = P->in[13] + (size_t)L * 2048 * IN_COLS;
    const float* w_uq = P->in[16] + (size_t)L * 512 * 768;
    const float* w_ukv = P->in[17] + (size_t)L * 256 * 1024;
    const float* pool_w = P->in[19] + (size_t)L * 4 * 128 * 128;
    const float* w_br = P->in[23] + (size_t)L * 2048 * 2048;
    const float* w_o = P->in[24] + (size_t)L * 2048 * 2048;
    const float* w_up = P->in[25] + (size_t)L * 2048 * 8192;
    const float* w_dn = P->in[26] + (size_t)L * 8192 * 2048;
    constexpr int I_IN = 32 * 400, I_UQ = 8 * 24, I_UKV = 4 * 32, I_POOL = 8 * 16, I_BR = 32 * 64, I_O = 32 * 64, I_UP = 32 * 256, I_DN = 128 * 64;
    constexpr int NIT = I_IN + I_UQ + I_UKV + I_POOL + I_BR + I_O + I_UP + I_DN;
    for (int it = gw; it < NIT; it += NGW) {
        int r = it;
        if (r < I_IN) { const int kb = r / 400, nb = r % 400, n0 = nb * 32;
            int src = (n0 < 768) ? n0 : (n0 < 4352) ? n0 + 32 : (n0 < 4384) ? n0 - 4352 + 768 : (n0 < 4608) ? -1 : n0 - 224;
            transpose_item(w_in, IN_COLS, kb * 64, src, WT + WT_IN, 2048, kb * 64, n0, scr, lane); continue; } r -= I_IN;
        if (r < I_UQ) { const int kb = r / 24, nb = r % 24; transpose_item(w_uq, 768, kb * 64, nb * 32, WT + WT_UQ, 512, kb * 64, nb * 32, scr, lane); continue; } r -= I_UQ;
        if (r < I_UKV) { const int kb = r / 32, nb = r % 32; transpose_item(w_ukv, 1024, kb * 64, nb * 32, WT + WT_UKV, 256, kb * 64, nb * 32, scr, lane); continue; } r -= I_UKV;
        if (r < I_POOL) { const int kb = r / 16, nb = r % 16; const int gk = (kb * 64) / 128, gn = (nb * 32) / 128;
            if (gk == gn) transpose_item(pool_w + (size_t)gk * 128 * 128, 128, kb * 64 - gk * 128, nb * 32 - gn * 128, WT + WT_POOL, 512, kb * 64, nb * 32, scr, lane);
            else transpose_item(pool_w, 128, 0, -1, WT + WT_POOL, 512, kb * 64, nb * 32, scr, lane);
            continue; } r -= I_POOL;
        if (r < I_BR) { const int kb = r / 64, nb = r % 64; transpose_item(w_br, 2048, kb * 64, nb * 32, WT + WT_BR, 2048, kb * 64, nb * 32, scr, lane); continue; } r -= I_BR;
        if (r < I_O) { const int kb = r / 64, nb = r % 64; transpose_item(w_o, 2048, kb * 64, nb * 32, WT + WT_O, 2048, kb * 64, nb * 32, scr, lane); continue; } r -= I_O;
        if (r < I_UP) { const int kb = r / 256, nb = r % 256; transpose_item(w_up, 8192, kb * 64, nb * 32, WT + WT_UP, 2048, kb * 64, nb * 32, scr, lane); continue; } r -= I_UP;
        { const int kb = r / 64, nb = r % 64; transpose_item(w_dn, 2048, kb * 64, nb * 32, WT + WT_DN, 8192, kb * 64, nb * 32, scr, lane); }
    }
}

__device__ __forceinline__ int cond_of_row(int m) { return m < NCTX ? 4 : ((m - NCTX) >> 12); }

__device__ __forceinline__ void norm_row0(int lane, const float* xin, const float* A, const float* B, bf16* hout) {
    f32x4 xv[8]; float ss = 0.f;
#pragma unroll
    for (int j = 0; j < 8; ++j) { xv[j] = *(const f32x4*)(xin + lane * 4 + 256 * j); ss += (xv[j].x * xv[j].x + xv[j].y * xv[j].y) + (xv[j].z * xv[j].z + xv[j].w * xv[j].w); }
    f32x4 av[8], bv[8];
#pragma unroll
    for (int j = 0; j < 8; ++j) { av[j] = *(const f32x4*)(A + lane * 4 + 256 * j); bv[j] = *(const f32x4*)(B + lane * 4 + 256 * j); }
    __builtin_amdgcn_sched_barrier(0);
    const float rstd = 1.0f / sqrtf(wave_sum(ss) * (1.0f / DM) + RMS_EPS);
#pragma unroll
    for (int j = 0; j < 8; ++j) { const int c = lane * 4 + 256 * j; const f32x4 h = xv[j] * rstd * av[j] + bv[j];
        v2u o; o.x = cvt_pk_bf16(h.x, h.y); o.y = cvt_pk_bf16(h.z, h.w); *(v2u*)(hout + c) = o; }
}
__device__ __forceinline__ void resnorm_phase(int lane, int gw, int NGW, const float* Xa, const float* Xb, float* X, const bf16* YB, const float* dGA, const float* dA, const float* dB, bf16* H, bool store_x) {
    int m = gw; if (m >= MTOK) return;
    f32x4 cx[8]; v2u cy[8];
#pragma unroll
    for (int j = 0; j < 8; ++j) { const float* xr = (m < NCTX) ? Xa + (size_t)m * DM : Xb + (size_t)(m - NCTX) * DM; cx[j] = __builtin_nontemporal_load((const f32x4*)(xr + lane * 4 + 256 * j)); cy[j] = __builtin_nontemporal_load((const v2u*)(YB + (size_t)m * DM + lane * 4 + 256 * j)); }
#pragma unroll 1
    while (m < MTOK) {
        const int mn = m + NGW; f32x4 nx[8]; v2u ny[8];
        if (mn < MTOK) {
#pragma unroll
            for (int j = 0; j < 8; ++j) { const float* xr = (mn < NCTX) ? Xa + (size_t)mn * DM : Xb + (size_t)(mn - NCTX) * DM; nx[j] = __builtin_nontemporal_load((const f32x4*)(xr + lane * 4 + 256 * j)); ny[j] = __builtin_nontemporal_load((const v2u*)(YB + (size_t)mn * DM + lane * 4 + 256 * j)); }
        } else {
#pragma unroll
            for (int j = 0; j < 8; ++j) { nx[j] = (f32x4){0.f, 0.f, 0.f, 0.f}; ny[j] = (v2u){0u, 0u}; }
        }
        const size_t co = (size_t)cond_of_row(m) * 12288 + lane * 4;
        f32x4 ga[8];
#pragma unroll
        for (int j = 0; j < 8; ++j) ga[j] = *(const f32x4*)(dGA + co + 256 * j);
        f32x4 yv[8]; float ss = 0.f;
#pragma unroll
        for (int j = 0; j < 8; ++j) { yv[j] = (f32x4){bflo(cy[j].x), bfhi(cy[j].x), bflo(cy[j].y), bfhi(cy[j].y)}; ss += (yv[j].x * yv[j].x + yv[j].y * yv[j].y) + (yv[j].z * yv[j].z + yv[j].w * yv[j].w); }
        const float rstd = 1.0f / sqrtf(wave_sum(ss) * (1.0f / DM) + RMS_EPS);
        float s2 = 0.f;
#pragma unroll
        for (int j = 0; j < 8; ++j) { cx[j] = cx[j] + ga[j] * (yv[j] * rstd); s2 += (cx[j].x * cx[j].x + cx[j].y * cx[j].y) + (cx[j].z * cx[j].z + cx[j].w * cx[j].w); }
        if (store_x) {
#pragma unroll
            for (int j = 0; j < 8; ++j) *(f32x4*)(X + (size_t)m * DM + lane * 4 + 256 * j) = cx[j];
        }
        if (H) {
            f32x4 av[8], bv[8];
#pragma unroll
            for (int j = 0; j < 8; ++j) { av[j] = *(const f32x4*)(dA + co + 256 * j); bv[j] = *(const f32x4*)(dB + co + 256 * j); }
            __builtin_amdgcn_sched_barrier(0);
            const float r2 = 1.0f / sqrtf(wave_sum(s2) * (1.0f / DM) + RMS_EPS);
#pragma unroll
            for (int j = 0; j < 8; ++j) { const f32x4 h = cx[j] * r2 * av[j] + bv[j];
                v2u o; o.x = cvt_pk_bf16(h.x, h.y); o.y = cvt_pk_bf16(h.z, h.w); *(v2u*)(H + (size_t)m * DM + lane * 4 + 256 * j) = o; }
        }
#pragma unroll
        for (int j = 0; j < 8; ++j) { cx[j] = nx[j]; cy[j] = ny[j]; }
        m = mn;
    }
}

constexpr int PH_PRO = 0, PH_MODSUM = 1, PH_T0 = 2, PH_L0 = 3, PH_PER_LAYER = 11, NPH = PH_L0 + NLAYER * PH_PER_LAYER;

__global__ void __launch_bounds__(NWAVES * 64, 2) trunk_fwd(KArgs args) {
    extern __shared__ __attribute__((aligned(16))) unsigned char lds[];
    LAS unsigned char* ldsL = (LAS unsigned char*)lds;
    volatile LAS unsigned* MISC = (volatile LAS unsigned*)(ldsL + MISC_OFF);
    const int G0 = gridDim.x; const int bx0 = blockIdx.x;
    const KAP kap0 = (KAP)__builtin_amdgcn_kernarg_segment_ptr();
    { gu32* ctl0 = (gu32*)(kap0->ws + WS_CTL); (void)ctl0; }
    for (int u = threadIdx.x; u < (LDS_BYTES - LDSCTL_OFF) / 4; u += NWAVES * 64) ((LAS unsigned*)(ldsL + LDSCTL_OFF))[u] = 0u;
    __syncthreads();
    XcdBarrier bar; bar.bar = (unsigned*)((gu32*)(kap0->ws + WS_CTL) + CW_BAR); bar.x = 0; bar.st = nullptr;
#if !MK_MULTI
    bar = xcd_barrier_post((unsigned*)((gu32*)(kap0->ws + WS_CTL) + CW_BAR), MISC + 8);
#endif
    const int lo = kap0->ph_lo, hi = kap0->ph_hi;
#define IN(k) (lo <= (k) && (k) < hi)
#if MK_MULTI
#define SEAM(k) do { } while (0)
#else
#define SEAM(k) do { if (IN(k) && IN((k) + 1)) xcd_barrier(bar); } while (0)
#endif
#define PHASE_ENV() \
    KAP P = kap0; asm volatile("" : "+s"(P)); unsigned char* ws = P->ws; (void)ws; \
    int G = G0, bx = bx0; asm volatile("" : "+s"(G), "+s"(bx)); const int vcu = (G % 8 == 0) ? (bx % 8) * (G / 8) + bx / 8 : bx; const int NGW = G * NWAVES; (void)vcu; (void)NGW; \
    int tid = threadIdx.x; asm volatile("" : "+v"(tid)); const int lane = tid & 63, wave = __builtin_amdgcn_readfirstlane(tid >> 6); const int gw = vcu * NWAVES + wave; (void)lane; (void)gw; \
    float* X = P->out; float* MOD = (float*)(ws + WS_MOD); float* ROPE_MLA = (float*)(ws + WS_ROPE_MLA); float* ROPE_DIFF = (float*)(ws + WS_ROPE_DIFF); float* MODP = (float*)(ws + WS_MODP); \
    bf16* WT = (bf16*)(ws + WS_WT); bf16* H = (bf16*)(ws + WS_H); bf16* PB = (bf16*)(ws + WS_P); bf16* GT = (bf16*)(ws + WS_GT); bf16* YB = (bf16*)(ws + WS_Y); \
    bf16* QN = (bf16*)(ws + WS_QN); bf16* CKV = (bf16*)(ws + WS_CKV); bf16* KR = (bf16*)(ws + WS_KR); bf16* POOLED = (bf16*)(ws + WS_POOLED); \
    bf16* QM = (bf16*)(ws + WS_QM); bf16* KVX = (bf16*)(ws + WS_KVX); \
    bf16* NAKC = (bf16*)(ws + WS_NAKC); bf16* NAVC = (bf16*)(ws + WS_NAVC); bf16* DKC = (bf16*)(ws + WS_DKC); bf16* DVC = (bf16*)(ws + WS_DVC); \
    float* DO = (float*)(ws + WS_DO); bf16* OALL = (bf16*)(ws + WS_OALL); const float* g_norm = P->in[12]; \
    (void)GT; (void)X; (void)MOD; (void)ROPE_MLA; (void)ROPE_DIFF; (void)MODP; (void)WT; (void)H; (void)PB; (void)YB; (void)QN; (void)CKV; (void)KR; (void)POOLED; (void)QM; (void)KVX; \
    (void)NAKC; (void)NAVC; (void)DKC; (void)DVC; (void)DO; (void)OALL; (void)g_norm;

    if ((PHMASK & 1) && IN(PH_PRO)) { PHASE_ENV();
        LAS float* scr = (LAS float*)(ldsL + wave * 9216);
        LAS float* S = (LAS float*)(ldsL + 73728);
        for (int i = tid; i < 5 * 2048; i += 512) { const int r = i >> 11, k = i & 2047; const float v = (r < 4) ? P->in[8][r * 2048 + k] : P->in[9][k]; S[i] = v / (1.0f + __expf(-v)); }
        __syncthreads();
        for (int it = gw; it < 4 * 48 * 16; it += NGW) {
            const int L = it / (48 * 16), rem = it % (48 * 16), cg = rem / 16, kc = rem % 16; const int n = cg * 256 + lane * 4;
            const float* W = P->in[10] + ((size_t)L * 2048 + kc * 128) * 12288 + n;
            f32x4 a0 = {0, 0, 0, 0}, a1 = a0, a2 = a0, a3 = a0, a4 = a0;
#pragma unroll 8
            for (int k = 0; k < 128; ++k) { const f32x4 w = __builtin_nontemporal_load((const f32x4*)(W + (size_t)k * 12288)); const int kk = kc * 128 + k;
                a0 += w * S[kk]; a1 += w * S[2048 + kk]; a2 += w * S[4096 + kk]; a3 += w * S[6144 + kk]; a4 += w * S[8192 + kk]; }
            float* o = MODP + ((size_t)(L * 16 + kc) * 5) * 12288 + n;
            *(f32x4*)(o) = a0; *(f32x4*)(o + 12288) = a1; *(f32x4*)(o + 2 * 12288) = a2; *(f32x4*)(o + 3 * 12288) = a3; *(f32x4*)(o + 4 * 12288) = a4;
        }
        for (int i = bx * 512 + tid; i < 4096 * 16; i += G * 512) { const int t = i >> 4, a = i & 15; const float pos = (a < 8) ? (float)(t >> 6) : (float)(t & 63);
            const float inv = powf(10000.0f, -(float)(a & 7) / 8.0f); const float ang = pos * inv; ROPE_MLA[t * 32 + a] = cosf(ang); ROPE_MLA[t * 32 + 16 + a] = sinf(ang); }
        for (int i = bx * 512 + tid; i < 4096 * 32; i += G * 512) { const int t = i >> 5, a = i & 31; const float pos = (a < 16) ? (float)(t >> 6) : (float)(t & 63);
            const float inv = powf(10000.0f, -(float)(a & 15) / 16.0f); const float ang = pos * inv; ROPE_DIFF[t * 64 + a] = cosf(ang); ROPE_DIFF[t * 64 + 32 + a] = sinf(ang); }
        wconv_layer(P, 0, scr, gw, NGW, lane);
        __syncthreads();
    }
    SEAM(PH_PRO);
    if ((PHMASK & 2) && IN(PH_MODSUM)) { PHASE_ENV();
        for (int i = bx * 512 + tid; i < 4 * 5 * 6 * 2048; i += G * 512) { const int n = i & 2047, k = (i >> 11) % 6, r = (i / (6 * 2048)) % 5, L = i / (5 * 6 * 2048);
            const int off = (k == 0) ? 4096 : (k == 1) ? 8192 : (k == 2) ? 6144 : (k == 3) ? 10240 : (k == 4) ? 2048 : 0;
            float sm = P->in[11][L * 12288 + off + n];
#pragma unroll
            for (int kc = 0; kc < 16; ++kc) sm += MODP[((size_t)(L * 16 + kc) * 5 + r) * 12288 + off + n];
            const float* gl = g_norm + (size_t)L * 4 * DM;
            const float v = (k == 0) ? sm * gl[DM + n] : (k == 1) ? gl[2 * DM + n] * (1.0f + sm) : (k == 2) ? sm : (k == 3) ? sm * gl[3 * DM + n] : (k == 4) ? gl[n] * (1.0f + sm) : sm;
            MOD[i] = v; }
    }
    SEAM(PH_MODSUM);
    if ((PHMASK & 4) && IN(PH_T0)) { PHASE_ENV();
        for (int m = gw; m < MTOK; m += NGW) {
            const float* xin = (m < NCTX) ? P->in[0] + (size_t)m * DM : P->in[1] + (size_t)(m - NCTX) * DM;
            const float* md = MOD + (size_t)cond_of_row(m) * 12288;
            norm_row0(lane, xin, md + 4 * 2048, md + 5 * 2048, H + (size_t)m * DM);
        }
    }
    SEAM(PH_T0);

    for (int L = 0; L < NLAYER; ++L) {
        const int pb = PH_L0 + L * PH_PER_LAYER;
#define gn (g_norm + (size_t)L * 4 * DM)
#define MODL (MOD + (size_t)L * 5 * 12288)
        if ((PHMASK & 8) && IN(pb + 0)) { PHASE_ENV();
            pg8::Gemm g{H, WT + WT_IN, MTOK, NW_IN, 2048, 2048, 2048}; pg8::StaticOrder S; S.init(MTOK, NW_IN, G, bx);
            pg8::Epi<pg8::EP_G1> E{PB, PW, 0, nullptr, GT, C_GATE / 256, P->out, L};
            for (int rep = 0; rep < REP_G1; ++rep) pg8::gemm_phase<pg8::Epi<pg8::EP_G1>>(ldsL, g, S, E);
        }
        SEAM(pb + 0);
        if ((PHMASK & 16) && IN(pb + 1)) { PHASE_ENV();
            const float* gq = P->in[14] + L * 512; const float* gkv = P->in[15] + L * 256;
            for (int rep = 0; rep < REP_T1; ++rep)
            for (int item = gw; item < MKV; item += NGW) {
                if (item < MTOK) {
                    const int m = item; const bool ctx = m < NCTX; bf16* pr = PB + (size_t)m * PW;
                    int b, p, T, mb; if (ctx) { b = m >> 8; p = m & 255; T = 256; mb = b * 256; } else { const int mm = m - NCTX; b = mm >> 12; p = mm & 4095; T = 4096; mb = NCTX + b * 4096; }
                    const size_t so = ((size_t)(b * 4 + L) * 256 + p);
                    const v4u wq = *(const v4u*)(pr + C_QC + lane * 8);
                    const v2u wkv = *(const v2u*)(pr + C_KVC + lane * 4);
                    const bf16 kr1 = pr[C_KR + (lane & 15)], kr2 = pr[C_KR + 16 + (lane & 15)];
                    const int blk = lane >> 3, i0 = (lane & 7) * 4;
                    v2u wqa = {0u, 0u}, wqb = wqa, wka = wqa, wkb = wqa; f32x4 rcs = {0.f, 0.f, 0.f, 0.f}, rsn = rcs; float mcs = 1.f, msn = 0.f;
                    if (!ctx) { wqa = *(const v2u*)(pr + C_DQ + blk * 64 + i0); wqb = *(const v2u*)(pr + C_DQ + blk * 64 + 32 + i0);
                                wka = *(const v2u*)(pr + C_DK + blk * 64 + i0); wkb = *(const v2u*)(pr + C_DK + blk * 64 + 32 + i0);
                                rcs = *(const f32x4*)(ROPE_DIFF + (size_t)p * 64 + i0); rsn = *(const f32x4*)(ROPE_DIFF + (size_t)p * 64 + 32 + i0);
                                mcs = ROPE_MLA[p * 32 + (lane & 15)]; msn = ROPE_MLA[p * 32 + 16 + (lane & 15)]; }
                    const int g = lane >> 4, half = 1 << g; const int lo_ = max(p - half, 0), hi_ = min(p + half, T);
                    v4u wp[16];
#pragma unroll
                    for (int d = 0; d < 16; ++d) { const int q = p + d - 8; const int qq = min(max(q, lo_), hi_ - 1);
                        wp[d] = *(const v4u*)(PB + (size_t)(mb + qq) * PW + C_POOL + lane * 8); }
                    __builtin_amdgcn_sched_barrier(0);
                    const f32x4 gq0 = *(const f32x4*)(gq + lane * 8), gq1 = *(const f32x4*)(gq + lane * 8 + 4), gk0 = *(const f32x4*)(gkv + lane * 4);
                    { float x[8] = {bflo(wq.x), bfhi(wq.x), bflo(wq.y), bfhi(wq.y), bflo(wq.z), bfhi(wq.z), bflo(wq.w), bfhi(wq.w)};
                      float ss = 0.f;
#pragma unroll
                      for (int e = 0; e < 8; ++e) ss += x[e] * x[e];
                      const float rstd = 1.0f / sqrtf(wave_sum(ss) * (1.0f / 512) + RMS_EPS);
                      v4u o; o.x = cvt_pk_bf16(x[0] * rstd * gq0.x, x[1] * rstd * gq0.y); o.y = cvt_pk_bf16(x[2] * rstd * gq0.z, x[3] * rstd * gq0.w);
                      o.z = cvt_pk_bf16(x[4] * rstd * gq1.x, x[5] * rstd * gq1.y); o.w = cvt_pk_bf16(x[6] * rstd * gq1.z, x[7] * rstd * gq1.w);
                      *(v4u*)(QN + (size_t)m * 512 + lane * 8) = o; }
                    { float x[4] = {bflo(wkv.x), bfhi(wkv.x), bflo(wkv.y), bfhi(wkv.y)};
                      const float ss = (x[0] * x[0] + x[1] * x[1]) + (x[2] * x[2] + x[3] * x[3]);
                      const float rstd = 1.0f / sqrtf(wave_sum(ss) * (1.0f / 256) + RMS_EPS);
                      const f32x4 v = {x[0] * rstd * gk0.x, x[1] * rstd * gk0.y, x[2] * rstd * gk0.z, x[3] * rstd * gk0.w};
                      v2u o; o.x = cvt_pk_bf16(v.x, v.y); o.y = cvt_pk_bf16(v.z, v.w);
                      *(v2u*)(CKV + (size_t)m * 256 + lane * 4) = o;
                      if (ctx) *(f32x4*)(P->out + OUT_CKV + so * 256 + lane * 4) = v; }
                    if (lane < 16) { const float x1 = bf1(kr1), x2 = bf1(kr2);
                      KR[(size_t)m * 32 + lane] = f2bf(x1 * mcs - x2 * msn); KR[(size_t)m * 32 + 16 + lane] = f2bf(x2 * mcs + x1 * msn); }
                    if (!ctx) {
#pragma unroll
                        for (int q = 0; q < 2; ++q) { bf16* base = pr + (q == 0 ? C_DQ : C_DK) + blk * 64 + i0; const v2u wa = q == 0 ? wqa : wka, wb = q == 0 ? wqb : wkb;
                            const f32x4 xa = {bflo(wa.x), bfhi(wa.x), bflo(wa.y), bfhi(wa.y)}, xb = {bflo(wb.x), bfhi(wb.x), bflo(wb.y), bfhi(wb.y)};
                            const f32x4 ya = xa * rcs - xb * rsn, yb = xb * rcs + xa * rsn;
                            v2u oa, ob2; oa.x = cvt_pk_bf16(ya.x, ya.y); oa.y = cvt_pk_bf16(ya.z, ya.w); ob2.x = cvt_pk_bf16(yb.x, yb.y); ob2.y = cvt_pk_bf16(yb.z, yb.w);
                            if (rep == REP_T1 - 1) { *(v2u*)base = oa; *(v2u*)(base + 32) = ob2; } }
                    }
                    { float acc8[8] = {0, 0, 0, 0, 0, 0, 0, 0};
#pragma unroll
                      for (int d = 0; d < 16; ++d) { const int q = p + d - 8; v4u w = wp[d]; if (!(q >= lo_ && q < hi_)) w = (v4u){0u, 0u, 0u, 0u};
                          acc8[0] += bflo(w.x); acc8[1] += bfhi(w.x); acc8[2] += bflo(w.y); acc8[3] += bfhi(w.y); acc8[4] += bflo(w.z); acc8[5] += bfhi(w.z); acc8[6] += bflo(w.w); acc8[7] += bfhi(w.w); }
                      const v4u ws_ = wp[8]; const float self[8] = {bflo(ws_.x), bfhi(ws_.x), bflo(ws_.y), bfhi(ws_.y), bflo(ws_.z), bfhi(ws_.z), bflo(ws_.w), bfhi(ws_.w)};
                      const float rc = 1.0f / (float)(hi_ - lo_);
                      v4u o; o.x = cvt_pk_bf16(acc8[0] * rc - self[0], acc8[1] * rc - self[1]); o.y = cvt_pk_bf16(acc8[2] * rc - self[2], acc8[3] * rc - self[3]);
                      o.z = cvt_pk_bf16(acc8[4] * rc - self[4], acc8[5] * rc - self[5]); o.w = cvt_pk_bf16(acc8[6] * rc - self[6], acc8[7] * rc - self[7]);
                      *(v4u*)(POOLED + (size_t)m * 512 + lane * 8) = o; }
                } else {
                    const int j = item - MTOK, b = j >> 9, jj = j & 511; const size_t cr = (size_t)(b * 4 + L) * 512 + jj;
                    { const f32x4 v = *(const f32x4*)(P->in[2] + cr * 256 + lane * 4); v2u o; o.x = cvt_pk_bf16(v.x, v.y); o.y = cvt_pk_bf16(v.z, v.w); *(v2u*)(CKV + (size_t)item * 256 + lane * 4) = o; }
                    if (lane < 32) KR[(size_t)item * 32 + lane] = f2bf(P->in[3][cr * 32 + lane]);
                    { f32x4 c0[4], c1[4];
#pragma unroll
                      for (int q = 0; q < 4; ++q) { const float* src = P->in[4 + q] + cr * 512 + lane * 8; c0[q] = *(const f32x4*)src; c1[q] = *(const f32x4*)(src + 4); }
                      __builtin_amdgcn_sched_barrier(0);
#pragma unroll
                      for (int q = 0; q < 4; ++q) { bf16* dst = ((q == 0) ? NAKC : (q == 1) ? NAVC : (q == 2) ? DKC : DVC) + (size_t)j * 512 + lane * 8;
                        v4u o; o.x = cvt_pk_bf16(c0[q].x, c0[q].y); o.y = cvt_pk_bf16(c0[q].z, c0[q].w); o.z = cvt_pk_bf16(c1[q].x, c1[q].y); o.w = cvt_pk_bf16(c1[q].z, c1[q].w); *(v4u*)dst = o; } }
                }
            }
        }
        SEAM(pb + 1);
        if ((PHMASK & 32) && IN(pb + 2)) { PHASE_ENV();
            _Pragma("unroll 1") for (int rep = 0; rep < REP_G2; ++rep) {
            { pg8::Gemm g{QN, WT + WT_UQ, MTOK, 768, 512, 512, 512}; pg8::StaticOrder S; S.init(MTOK, 768, G, bx);
              pg8::Epi<pg8::EP_BF16> E{QM, 768, 0, nullptr, nullptr, 0, nullptr, 0}; pg8::gemm_phase<pg8::Epi<pg8::EP_BF16>>(ldsL, g, S, E); }
            { pg8::Gemm g{CKV, WT + WT_UKV, MKV, 1024, 256, 256, 256}; pg8::StaticOrder S; S.init(MKV, 1024, G, bx);
              pg8::Epi<pg8::EP_BF16> E{KVX, 1024, 0, nullptr, nullptr, 0, nullptr, 0}; pg8::gemm_phase<pg8::Epi<pg8::EP_BF16>>(ldsL, g, S, E); }
            { pg8::Gemm g{POOLED, WT + WT_POOL, MTOK, 512, 512, 512, 512}; pg8::StaticOrder S; S.init(MTOK, 512, G, bx);
              pg8::Epi<pg8::EP_POOL> E{OALL, 2048, 1024, P->in[20] + L * 512, nullptr, 0, nullptr, 0}; pg8::gemm_phase<pg8::Epi<pg8::EP_POOL>>(ldsL, g, S, E); }
            }
        }
        SEAM(pb + 2);
        if ((PHMASK & 64) && IN(pb + 3)) { PHASE_ENV();
            char* al = (char*)lds;
            for (int rep = 0; rep < REP_A1; ++rep) {
            if (ATTMASK & 1)
            _Pragma("unroll 1") for (int rp_ = 0; rp_ < 1 + ((ATTREP >> 0) & 1); ++rp_)
            for (int u = vcu; u < 256; u += G) { const int b = u >> 3, h = u & 7; const size_t m0 = (size_t)b * 256;
                att::Args a{}; a.Q = QM + m0 * 768 + h * 96; a.ldq = 768;
                a.K1A = KVX + m0 * 1024 + h * 128; a.K1B = a.K1A; a.ldk1A = 1024; a.ldk1B = 1024; a.K2A = KR + m0 * 32; a.K2B = a.K2A;
                a.VA = KVX + m0 * 1024 + h * 128 + 64; a.VB = a.VA; a.ldvA = 1024; a.ldvB = 1024; a.nA = 4; a.NT = 4;
                a.O = OALL + m0 * 2048 + h * 64; a.ldo = 2048; a.rope = nullptr; a.t0 = 0; a.rpb = nullptr; a.r0 = 0; a.kr_lo = 0;
                att::attn_unit<att::CfgMLA>(a, al); }
            if (ATTMASK & 2)
            _Pragma("unroll 1") for (int rp_ = 0; rp_ < 1 + ((ATTREP >> 1) & 1); ++rp_)
            for (int u = vcu; u < 512; u += G) { const int qb = u & 15, h = (u >> 4) & 7, b = u >> 7; const size_t mb = NCTX + (size_t)b * 4096, m0 = mb + qb * 256; const size_t cb = MTOK + (size_t)b * 512;
                att::Args a{}; a.Q = QM + m0 * 768 + h * 96; a.ldq = 768;
                a.K1A = KVX + mb * 1024 + h * 128; a.K1B = KVX + cb * 1024 + h * 128; a.ldk1A = 1024; a.ldk1B = 1024; a.K2A = KR + mb * 32; a.K2B = KR + cb * 32;
                a.VA = KVX + mb * 1024 + h * 128 + 64; a.VB = KVX + cb * 1024 + h * 128 + 64; a.ldvA = 1024; a.ldvB = 1024; a.nA = 64; a.NT = 72;
                a.O = OALL + m0 * 2048 + h * 64; a.ldo = 2048; a.rope = ROPE_MLA; a.t0 = qb * 256; a.rpb = nullptr; a.r0 = 0; a.kr_lo = 0;
                att::attn_unit<att::CfgMLA>(a, al); }
            if (ATTMASK & 4)
            _Pragma("unroll 1") for (int rp_ = 0; rp_ < 1 + ((ATTREP >> 2) & 1); ++rp_)
            for (int u = vcu; u < 256; u += G) { const int b = u >> 3, h = u & 7; const size_t m0 = (size_t)b * 256;
                att::Args a{}; a.Q = PB + m0 * PW + C_NAQ + h * 64; a.ldq = PW;
                a.K1A = PB + m0 * PW + C_NAK + h * 64; a.K1B = a.K1A; a.ldk1A = PW; a.ldk1B = PW; a.K2A = nullptr; a.K2B = nullptr;
                a.VA = PB + m0 * PW + C_NAV + h * 64; a.VB = a.VA; a.ldvA = PW; a.ldvB = PW; a.nA = 4; a.NT = 4;
                a.O = OALL + m0 * 2048 + 512 + h * 64; a.ldo = 2048; a.rope = nullptr; a.t0 = 0; a.rpb = nullptr; a.r0 = 0; a.kr_lo = 0;
                att::attn_unit<att::CfgNA>(a, al); }
            if (ATTMASK & 8)
            _Pragma("unroll 1") for (int rp_ = 0; rp_ < 1 + ((ATTREP >> 3) & 1); ++rp_)
            for (int u = vcu; u < 512; u += G) { const int rg = u & 15, h = (u >> 4) & 7, b = u >> 7; const size_t mb = NCTX + (size_t)b * 4096; const int r0 = rg * 4;
                const int kr_lo = min(max(r0 - 4, 0), 56), kr_hi = min(max(r0 + 3 - 4, 0), 56) + 8; const size_t m0 = mb + (size_t)r0 * 64;
                att::Args a{}; a.Q = PB + m0 * PW + C_NAQ + h * 64; a.ldq = PW;
                a.K1A = PB + (mb + (size_t)kr_lo * 64) * PW + C_NAK + h * 64; a.ldk1A = PW; a.K1B = NAKC + (size_t)b * 512 * 512 + h * 64; a.ldk1B = 512; a.K2A = nullptr; a.K2B = nullptr;
                a.VA = PB + (mb + (size_t)kr_lo * 64) * PW + C_NAV + h * 64; a.ldvA = PW; a.VB = NAVC + (size_t)b * 512 * 512 + h * 64; a.ldvB = 512;
                a.nA = kr_hi - kr_lo; a.NT = a.nA + 8;
                a.O = OALL + m0 * 2048 + 512 + h * 64; a.ldo = 2048; a.rope = nullptr; a.t0 = 0;
                a.rpb = P->in[18] + ((size_t)L * 8 + h) * 15 * 31; a.r0 = r0; a.kr_lo = kr_lo;
                att::attn_unit<att::CfgNAW>(a, al); }
            const float* lp = P->in[21] + L * 256; const float lam_init = 0.8f - 0.6f * expf(-0.3f * (float)L);
            const float lam = expf(wave_sum(lp[lane] * lp[64 + lane])) - expf(wave_sum(lp[128 + lane] * lp[192 + lane])) + lam_init;
            if (ATTMASK & 16)
            _Pragma("unroll 1") for (int rp_ = 0; rp_ < 1 + ((ATTREP >> 4) & 1); ++rp_)
            for (int u = vcu; u < 128; u += G) { const int b = u >> 2, h = u & 3; const size_t m0 = (size_t)b * 256;
                _Pragma("unroll 1") for (int mp = 0; mp < 2; ++mp) {
                att::Args a{}; a.Q = PB + m0 * PW + C_DQ + h * 128 + mp * 64; a.ldq = PW;
                a.K1A = PB + m0 * PW + C_DK + h * 128 + mp * 64; a.K1B = a.K1A; a.ldk1A = PW; a.ldk1B = PW; a.K2A = nullptr; a.K2B = nullptr;
                a.VA = PB + m0 * PW + C_DV + h * 128; a.VB = a.VA; a.ldvA = PW; a.ldvB = PW; a.nA = 4; a.NT = 4;
                a.O = DO + m0 * 512 + h * 128; a.ldo = 512; a.rope = nullptr; a.t0 = 0; a.rpb = nullptr; a.r0 = 0; a.kr_lo = 0;
                a.comb = mp; a.lam = lam; a.post = 1.0f - lam_init; a.ng = P->in[22] + L * 128; a.Of = OALL + m0 * 2048 + 1536 + h * 128; a.ldof = 2048;
                att::attn_unit<att::CfgDIFF>(a, al); } }
            if (ATTMASK & 32)
            _Pragma("unroll 1") for (int rp_ = 0; rp_ < 1 + ((ATTREP >> 5) & 1); ++rp_)
            for (int u = vcu; u < 256; u += G) { const int qb = u & 15, h = (u >> 4) & 3, b = u >> 6; const size_t mb = NCTX + (size_t)b * 4096, m0 = mb + qb * 256;
                _Pragma("unroll 1") for (int mp = 0; mp < 2; ++mp) {
                att::Args a{}; a.Q = PB + m0 * PW + C_DQ + h * 128 + mp * 64; a.ldq = PW;
                a.K1A = PB + mb * PW + C_DK + h * 128 + mp * 64; a.ldk1A = PW; a.K1B = DKC + (size_t)b * 512 * 512 + h * 128 + mp * 64; a.ldk1B = 512; a.K2A = nullptr; a.K2B = nullptr;
                a.VA = PB + mb * PW + C_DV + h * 128; a.ldvA = PW; a.VB = DVC + (size_t)b * 512 * 512 + h * 128; a.ldvB = 512; a.nA = 64; a.NT = 72;
                a.O = DO + m0 * 512 + h * 128; a.ldo = 512; a.rope = nullptr; a.t0 = 0; a.rpb = nullptr; a.r0 = 0; a.kr_lo = 0;
                a.comb = mp; a.lam = lam; a.post = 1.0f - lam_init; a.ng = P->in[22] + L * 128; a.Of = OALL + m0 * 2048 + 1536 + h * 128; a.ldof = 2048;
                att::attn_unit<att::CfgDIFF>(a, al); } }
            }
            __syncthreads();
        }
#if !MK_MULTI
        if (IN(pb + 3) && IN(pb + 5)) xcd_barrier(bar);
#endif
        if ((PHMASK & 256) && IN(pb + 5)) { PHASE_ENV();
            pg8::Gemm g{OALL, WT + WT_BR, MTOK, 2048, 2048, 2048, 2048}; pg8::StaticOrder S; S.init(MTOK, 2048, G, bx);
            pg8::Epi<pg8::EP_MERGE> E{H, 2048, 0, nullptr, GT, 0, nullptr, 0};
            _Pragma("unroll 1") for (int rep = 0; rep < REP_G3; ++rep) pg8::gemm_phase<pg8::Epi<pg8::EP_MERGE>>(ldsL, g, S, E);
        }
        SEAM(pb + 5);
        if ((PHMASK & 512) && IN(pb + 6)) { PHASE_ENV();
            pg8::Gemm g{H, WT + WT_O, MTOK, 2048, 2048, 2048, 2048}; pg8::StaticOrder S; S.init(MTOK, 2048, G, bx);
            pg8::Epi<pg8::EP_BF16> E{YB, 2048, 0, nullptr, nullptr, 0, nullptr, 0};
            _Pragma("unroll 1") for (int rep = 0; rep < REP_G4; ++rep) pg8::gemm_phase<pg8::Epi<pg8::EP_BF16>>(ldsL, g, S, E);
        }
        SEAM(pb + 6);
        if ((PHMASK & 1024) && IN(pb + 7)) { PHASE_ENV();
            _Pragma("unroll 1") for (int rep = 0; rep < REP_T23; ++rep)
                resnorm_phase(lane, gw, NGW, (L == 0) ? P->in[0] : X, (L == 0) ? P->in[1] : X + (size_t)NCTX * DM, X, YB, MODL, MODL + 2048, MODL + 2 * 2048, H, rep == REP_T23 - 1);
        }
        SEAM(pb + 7);
        if ((PHMASK & 2048) && IN(pb + 8)) { PHASE_ENV();
            pg8::Gemm g{H, WT + WT_UP, MTOK, FF, 2048, 2048, 2048}; pg8::StaticOrder S; S.init(MTOK, FF, G, bx);
            pg8::Epi<pg8::EP_RELU2> E{GT, FF, 0, nullptr, nullptr, 0, nullptr, 0};
            _Pragma("unroll 1") for (int rep = 0; rep < REP_G56; ++rep) pg8::gemm_phase<pg8::Epi<pg8::EP_RELU2>>(ldsL, g, S, E);
        }
        SEAM(pb + 8);
        if ((PHMASK & 4096) && IN(pb + 9)) { PHASE_ENV();
            pg8::Gemm g{GT, WT + WT_DN, MTOK, 2048, FF, FF, FF}; pg8::StaticOrder S; S.init(MTOK, 2048, G, bx);
            pg8::Epi<pg8::EP_BF16> E{YB, 2048, 0, nullptr, nullptr, 0, nullptr, 0};
            _Pragma("unroll 1") for (int rep = 0; rep < REP_G56; ++rep) pg8::gemm_phase<pg8::Epi<pg8::EP_BF16>>(ldsL, g, S, E);
        }
        SEAM(pb + 9);
        if ((PHMASK & 8192) && IN(pb + 10)) { PHASE_ENV();
            const bool more = (L + 1 < NLAYER);
            const float* MODN = MOD + (size_t)(more ? L + 1 : L) * 5 * 12288;
            _Pragma("unroll 1") for (int rep = 0; rep < REP_T23; ++rep)
                resnorm_phase(lane, gw, NGW, X, X + (size_t)NCTX * DM, X, YB, MODL + 3 * 2048, MODN + 4 * 2048, MODN + 5 * 2048, more ? H : nullptr, rep == REP_T23 - 1);
            if (more) { LAS float* scr = (LAS float*)(ldsL + wave * 9216); wconv_layer(P, L + 1, scr, gw, NGW, lane); }
        }
        SEAM(pb + 10);
    }
#undef gn
#undef MODL
#undef IN
#undef SEAM
}

extern "C" void kernel_launch(void* const* d_in, const int* in_sizes, int n_in, void* d_out, int out_size, void* d_ws, size_t ws_size, hipStream_t stream) {
    static int grid = 0;
    if (grid == 0) {
        if (n_in != 27 || (size_t)out_size != OUT_END || ws_size < WS_END) { fprintf(stderr, "kernel_launch: shape mismatch n_in %d out %d ws %zu (need %zu)\n", n_in, out_size, ws_size, (size_t)WS_END); grid = -1; return; }
        int dev = 0, cus = 0, per_cu = 0;
        if (hipGetDevice(&dev) != hipSuccess || hipDeviceGetAttribute(&cus, hipDeviceAttributeMultiprocessorCount, dev) != hipSuccess) { grid = -1; return; }
        if (hipFuncSetAttribute((const void*)trunk_fwd, hipFuncAttributeMaxDynamicSharedMemorySize, LDS_BYTES) != hipSuccess) { fprintf(stderr, "kernel_launch: hipFuncSetAttribute failed\n"); grid = -1; return; }
        if (hipOccupancyMaxActiveBlocksPerMultiprocessor(&per_cu, (const void*)trunk_fwd, NWAVES * 64, LDS_BYTES) != hipSuccess || per_cu < 1)
            fprintf(stderr, "kernel_launch: occupancy query reports %d\n", per_cu);
        (void)hipGetLastError();
        grid = cus;
    }
    if (grid < 0) return;
    if (hipMemsetAsync((char*)d_ws + WS_CTL, 0, CTL_ZERO_BYTES, stream) != hipSuccess) return;
    KArgs a{};
    for (int i = 0; i < 27; ++i) a.in[i] = (const float*)d_in[i];
    a.out = (float*)d_out; a.ws = (unsigned char*)d_ws;
#if MK_MULTI
    for (int ph = 0; ph < NPH; ++ph) { a.ph_lo = ph; a.ph_hi = ph + 1; hipLaunchKernelGGL(trunk_fwd, dim3(grid), dim3(NWAVES * 64), LDS_BYTES, stream, a); }
#else
    a.ph_lo = 0; a.ph_hi = NPH;
    hipLaunchKernelGGL(trunk_fwd, dim3(grid), dim3(NWAVES * 64), LDS_BYTES, stream, a);
#endif
    const hipError_t le = hipPeekAtLastError();
    if (le != hipSuccess) fprintf(stderr, "kernel_launch: launch failed: %s\n", hipGetErrorName(le));
}
```
